# Optimizing an MI355X kernel written in HIP

```python
import math
import jax, jax.numpy as jnp
from jax import lax
import numpy as np


D_MODEL = 1024
BATCH = 32
SEQ = 256
DEPTH = 2
DEC_BATCH = 2
DEC_SEQ = 1024
PAST_LEN = 512

GRID_W = 64
SC_W = 256
HY_W = 256
ML_W = 512
ML_H = 4
ML_DH = ML_W // ML_H
D_FF = 4 * D_MODEL
HY_ORDER = 2
HY_BANDS = 16
HY_EMB = 1 + 2 * HY_BANDS
HY_HID = 64
HY_DECAY_SHORT = 0.3
HY_DECAY_LONG = 1.5
HY_DECAY_TARGET = 1e-2
CHUNK = 64
EPS = 1e-6
N_IN = 3 * SC_W + 3 * HY_W + 4 * ML_W + 4 * ML_H

kernel_name = "hybrid_conv_hyena_mlstm_prefix_dit_step"

F32 = jnp.float32


def rmsnorm(x, g):
    xf = x.astype(F32)
    y = xf * lax.rsqrt(jnp.mean(xf * xf, axis=-1, keepdims=True) + EPS)
    return (y * g.astype(F32)).astype(x.dtype)


def short_conv(x, w):
    xp = jnp.pad(x, ((0, 0), (1, 1), (0, 0)))
    return xp[:, :-2] * w[0] + xp[:, 1:-1] * w[1] + xp[:, 2:] * w[2]


def grid_pos_embed(L):
    rows = L // GRID_W
    r, cidx = jnp.meshgrid(jnp.arange(rows, dtype=F32), jnp.arange(GRID_W, dtype=F32), indexing='ij')
    r = r.reshape(-1)
    cidx = cidx.reshape(-1)
    quarter = D_MODEL // 4
    omega = 1.0 / (10000.0 ** (jnp.arange(quarter, dtype=F32) / quarter))
    ar = r[:, None] * omega[None, :]
    ac = cidx[:, None] * omega[None, :]
    return jnp.concatenate([jnp.sin(ar), jnp.cos(ar), jnp.sin(ac), jnp.cos(ac)], axis=-1)


def hyena_filters(L, w1, b1, w2, b2, w3, freq):
    t_idx = jnp.arange(L, dtype=F32)
    t = t_idx / (L - 1)
    bands = jnp.arange(1, HY_BANDS + 1, dtype=F32)
    ang = 2.0 * math.pi * t_idx[:, None] * bands[None, :] / L
    z = jnp.concatenate([t[:, None], jnp.cos(ang), -jnp.sin(ang)], axis=-1)
    f = freq.astype(F32)
    hdn = jnp.sin(f * (z @ w1.astype(F32) + b1.astype(F32)))
    hdn = jnp.sin(f * (hdn @ w2.astype(F32) + b2.astype(F32)))
    h = (hdn @ w3.astype(F32)).reshape(L, HY_ORDER, 2, HY_W)
    deltas = jnp.abs(jnp.linspace(math.log(HY_DECAY_TARGET) / HY_DECAY_LONG,
                                  math.log(HY_DECAY_TARGET) / HY_DECAY_SHORT, HY_W, dtype=F32))
    h = h * jnp.exp(-t[:, None] * deltas[None, :])[:, None, None, :]
    fwd = h[:, :, 0]
    bwd = h[1:, :, 1][::-1]
    full = jnp.concatenate([fwd, jnp.zeros((1, HY_ORDER, HY_W), F32), bwd], axis=0)
    return full / jnp.sum(jnp.abs(full), axis=0, keepdims=True)


def hyena_mix(u3, conv_w, w1, b1, w2, b2, w3, freq, skip):
    B, L, _ = u3.shape
    u3 = short_conv(u3, conv_w).astype(F32)
    v, x1, x2 = jnp.split(u3, 3, axis=-1)
    Hf = jnp.fft.rfft(hyena_filters(L, w1, b1, w2, b2, w3, freq), axis=0)
    z = v
    for o, gate in enumerate((x1, x2)):
        Z = jnp.fft.rfft(z, n=2 * L, axis=1)
        zc = jnp.fft.irfft(Z * Hf[None, :, o], n=2 * L, axis=1)[:, :L]
        z = gate * (zc + skip[o].astype(F32) * z)
    return z


def mlstm_chunkwise(q, k, v, i_pre, logf, C0, n0, m0):
    B, H, L, DH = q.shape
    nc = L // CHUNK

    def to_chunks(a):
        return jnp.moveaxis(a.reshape(B, H, nc, CHUNK, *a.shape[3:]), 2, 0)

    causal = jnp.tril(jnp.ones((CHUNK, CHUNK), bool))

    def step(carry, xs):
        C, n, m = carry
        qq, kk, vv, ii, ff = xs
        b = jnp.cumsum(ff, axis=-1)
        log_d = jnp.where(causal, b[..., :, None] - b[..., None, :] + ii[..., None, :], -jnp.inf)
        log_prev = b + m[..., None]
        m_t = jnp.maximum(log_prev, jnp.max(log_d, axis=-1))
        d = jnp.exp(log_d - m_t[..., None])
        w_prev = jnp.exp(log_prev - m_t)
        s = jnp.einsum('bhtd,bhsd->bhts', qq, kk) * d
        num = jnp.einsum('bhts,bhsd->bhtd', s, vv) + w_prev[..., None] * jnp.einsum('bhtk,bhkv->bhtv', qq, C)
        den = jnp.sum(s, axis=-1) + w_prev * jnp.einsum('bhtk,bhk->bht', qq, n)
        h = num / jnp.maximum(jnp.abs(den), jnp.exp(-m_t))[..., None]
        bL = b[..., -1]
        log_s = bL[..., None] - b + ii
        m_new = jnp.maximum(bL + m, jnp.max(log_s, axis=-1))
        w_s = jnp.exp(log_s - m_new[..., None])
        w_c = jnp.exp(bL + m - m_new)
        C_new = w_c[..., None, None] * C + jnp.einsum('bhs,bhsk,bhsv->bhkv', w_s, kk, vv)
        n_new = w_c[..., None] * n + jnp.einsum('bhs,bhsk->bhk', w_s, kk)
        return (C_new, n_new, m_new), h

    carry0 = (C0.astype(F32), n0.astype(F32), m0.astype(F32))
    xs = tuple(to_chunks(a) for a in (q, k, v, i_pre, logf))
    (C, n, m), hs = lax.scan(step, carry0, xs)
    h = jnp.moveaxis(hs, 0, 2).reshape(B, H, L, DH)
    return h, C, n, m


def mlstm_mix(qkvo, gates, conv_w, gate_b, norm_g, C0, n0, m0):
    B, L, _ = qkvo.shape
    qk = jax.nn.silu(short_conv(qkvo[..., :2 * ML_W], conv_w))
    q, k = jnp.split(qk, 2, axis=-1)
    v = qkvo[..., 2 * ML_W:3 * ML_W]
    o = qkvo[..., 3 * ML_W:]

    def heads(a):
        return a.astype(F32).reshape(B, L, ML_H, ML_DH).transpose(0, 2, 1, 3)

    q, k, v = heads(q), heads(k) * (ML_DH ** -0.5), heads(v)
    g = (gates.astype(F32) + gate_b.astype(F32)).reshape(B, L, 2, 2, ML_H).transpose(2, 3, 0, 4, 1)
    h_f, Cf, nf, mf = mlstm_chunkwise(q, k, v, g[0, 0], jax.nn.log_sigmoid(g[0, 1]), C0[:, 0], n0[:, 0], m0[:, 0])
    flip = lambda a: jnp.flip(a, axis=2)
    h_b, Cb, nb, mb = mlstm_chunkwise(flip(q), flip(k), flip(v), flip(g[1, 0]), flip(jax.nn.log_sigmoid(g[1, 1])),
                                      C0[:, 1], n0[:, 1], m0[:, 1])
    h = h_f + flip(h_b)
    h = h * lax.rsqrt(jnp.mean(h * h, axis=-1, keepdims=True) + EPS)
    h = h.transpose(0, 2, 1, 3).reshape(B, L, ML_W) * norm_g.astype(F32)
    h = jax.nn.sigmoid(o.astype(F32)) * h
    return h, jnp.stack([Cf, Cb], axis=1), jnp.stack([nf, nb], axis=1), jnp.stack([mf, mb], axis=1)


def layer(x, mod, norm1_g, w_in, sc_conv_w, hy_conv_w, hy_w1, hy_b1, hy_w2, hy_b2, hy_w3, hy_freq, hy_skip,
          ml_conv_w, ml_gate_b, ml_norm_g, w_out, norm2_g, mlp_w1, mlp_w2, C0, n0, m0):
    sh1, sc1, g1, sh2, sc2, g2 = jnp.split(mod[:, None, :], 6, axis=-1)
    u = rmsnorm(x, norm1_g) * (1 + sc1) + sh1
    proj = u @ w_in
    o1 = 3 * SC_W
    o2 = o1 + 3 * HY_W
    o3 = o2 + 4 * ML_W
    b_g, c_g, xin = jnp.split(proj[..., :o1], 3, axis=-1)
    y_sc = (b_g * short_conv(c_g * xin, sc_conv_w)).astype(F32)
    y_hy = hyena_mix(proj[..., o1:o2], hy_conv_w, hy_w1, hy_b1, hy_w2, hy_b2, hy_w3, hy_freq, hy_skip)
    y_ml, C, n, m = mlstm_mix(proj[..., o2:o3], proj[..., o3:], ml_conv_w, ml_gate_b, ml_norm_g, C0, n0, m0)
    y = jnp.concatenate([y_sc, y_hy, y_ml], axis=-1).astype(x.dtype)
    x = x + g1 * (y @ w_out)
    u = rmsnorm(x, norm2_g) * (1 + sc2) + sh2
    x = x + g2 * (jnp.square(jax.nn.relu(u @ mlp_w1)) @ mlp_w2)
    return x, C, n, m


def setup_inputs(seed: int = 0) -> dict:
    key = jax.random.key(seed)
    ks = jax.random.split(key, 32)
    nrm = lambda k, shape, s: jax.random.normal(k, shape, F32) * s
    f_bias = jnp.linspace(3.0, 6.0, ML_H, dtype=F32)[None, None, None, :] + nrm(ks[24], (DEPTH, 2, 1, ML_H), 0.1)
    i_bias = nrm(ks[25], (DEPTH, 2, 1, ML_H), 0.1)
    ml_gate_b = jnp.concatenate([i_bias, f_bias], axis=2).reshape(DEPTH, 4 * ML_H)
    return {
        "x_prompt": nrm(ks[0], (BATCH, SEQ, D_MODEL), 1.0),
        "x_sample": nrm(ks[1], (DEC_BATCH, DEC_SEQ, D_MODEL), 1.0),
        "state_C": nrm(ks[2], (DEC_BATCH, DEPTH, 2, ML_H, ML_DH, ML_DH), 0.3),
        "state_n": nrm(ks[3], (DEC_BATCH, DEPTH, 2, ML_H, ML_DH), 0.3),
        "state_m": nrm(ks[4], (DEC_BATCH, DEPTH, 2, ML_H), 0.5),
        "c": nrm(ks[5], (DEC_BATCH, D_MODEL), 1.0),
        "c_ctx": nrm(ks[6], (D_MODEL,), 1.0),
        "norm1_g": 1.0 + nrm(ks[7], (DEPTH, D_MODEL), 0.02),
        "ada_w": nrm(ks[8], (DEPTH, D_MODEL, 6 * D_MODEL), 0.5 * D_MODEL ** -0.5),
        "ada_b": nrm(ks[9], (DEPTH, 6 * D_MODEL), 0.02),
        "w_in": nrm(ks[10], (DEPTH, D_MODEL, N_IN), D_MODEL ** -0.5),
        "sc_conv_w": nrm(ks[11], (DEPTH, 3, SC_W), 0.5),
        "hy_conv_w": nrm(ks[12], (DEPTH, 3, 3 * HY_W), 0.5),
        "hy_w1": nrm(ks[13], (DEPTH, HY_EMB, HY_HID), HY_EMB ** -0.5),
        "hy_b1": nrm(ks[14], (DEPTH, HY_HID), 0.1),
        "hy_w2": nrm(ks[15], (DEPTH, HY_HID, HY_HID), HY_HID ** -0.5),
        "hy_b2": nrm(ks[16], (DEPTH, HY_HID), 0.1),
        "hy_w3": nrm(ks[17], (DEPTH, HY_HID, HY_ORDER * 2 * HY_W), HY_HID ** -0.5),
        "hy_freq": 1.0 + nrm(ks[18], (DEPTH, HY_HID), 0.1),
        "hy_skip": nrm(ks[19], (DEPTH, HY_ORDER, HY_W), 0.5),
        "ml_conv_w": nrm(ks[20], (DEPTH, 3, 2 * ML_W), 0.5),
        "ml_gate_b": ml_gate_b,
        "ml_norm_g": 1.0 + nrm(ks[21], (DEPTH, ML_W), 0.02),
        "w_out": nrm(ks[22], (DEPTH, D_MODEL, D_MODEL), D_MODEL ** -0.5),
        "norm2_g": 1.0 + nrm(ks[23], (DEPTH, D_MODEL), 0.02),
        "mlp_w1": nrm(ks[26], (DEPTH, D_MODEL, D_FF), D_MODEL ** -0.5),
        "mlp_w2": nrm(ks[27], (DEPTH, D_FF, D_MODEL), D_FF ** -0.5),
        "norm_f_g": 1.0 + nrm(ks[28], (D_MODEL,), 0.02),
    }


def reference(x_prompt, x_sample, state_C, state_n, state_m, c, c_ctx, norm1_g, ada_w, ada_b, w_in,
              sc_conv_w, hy_conv_w, hy_w1, hy_b1, hy_w2, hy_b2, hy_w3, hy_freq, hy_skip, ml_conv_w,
              ml_gate_b, ml_norm_g, w_out, norm2_g, mlp_w1, mlp_w2, norm_f_g):
    def run(x, mod, l, C0, n0, m0):
        return layer(x, mod, norm1_g[l], w_in[l], sc_conv_w[l], hy_conv_w[l], hy_w1[l], hy_b1[l], hy_w2[l],
                     hy_b2[l], hy_w3[l], hy_freq[l], hy_skip[l], ml_conv_w[l], ml_gate_b[l], ml_norm_g[l],
                     w_out[l], norm2_g[l], mlp_w1[l], mlp_w2[l], C0, n0, m0)

    B = x_prompt.shape[0]
    zC = jnp.zeros((B, 2, ML_H, ML_DH, ML_DH), F32)
    zn = jnp.zeros((B, 2, ML_H, ML_DH), F32)
    zm = jnp.zeros((B, 2, ML_H), F32)
    sc_ctx = jax.nn.silu(c_ctx)[None, :]
    xp = x_prompt
    Cs, ns, ms = [], [], []
    for l in range(DEPTH):
        mod = sc_ctx @ ada_w[l] + ada_b[l]
        xp, C, n, m = run(xp, mod, l, zC, zn, zm)
        Cs.append(C)
        ns.append(n)
        ms.append(m)
    y_prompt = rmsnorm(xp, norm_f_g)
    new_state_C = jnp.stack(Cs, axis=1)
    new_state_n = jnp.stack(ns, axis=1)
    new_state_m = jnp.stack(ms, axis=1)

    L = x_sample.shape[1]
    xs = x_sample + grid_pos_embed(L).astype(x_sample.dtype)[None]
    sc_lat = jax.nn.silu(c)
    for l in range(DEPTH):
        mod = sc_lat @ ada_w[l] + ada_b[l]
        xs, _, _, _ = run(xs, mod, l, state_C[:, l], state_n[:, l], state_m[:, l])
    y_sample = rmsnorm(xs, norm_f_g)
    return (y_prompt, y_sample, new_state_C, new_state_n, new_state_m)
```

```cpp
#define MK_ONE_LAUNCH 0
#include <hip/hip_runtime.h>
#include <hip/hip_cooperative_groups.h>
#include <cstdio>
#include <cstdint>
namespace cg = cooperative_groups;
namespace pg8 {
#define PG8_LAS __attribute__((address_space(3)))
typedef unsigned short bf16_t;
typedef short bf16x8 __attribute__((ext_vector_type(8)));
typedef float f32x4 __attribute__((ext_vector_type(4)));
typedef unsigned u32x4 __attribute__((ext_vector_type(4)));
constexpr int BM = 256, BK = 64, HALF = 128, HTB = HALF * BK * 2  , STAGE_BYTES = 8 * HTB, NXCD = 8, WGM = 8;

__host__ __device__ __forceinline__ int lds_byte(int r, int c) { const int st = (r >> 4) * 2 + (c >> 5), rr = r & 15, cc = c & 31, ob = rr * 64 + cc * 2; return st * 1024 + (ob ^ (((ob >> 9) & 1) << 5)); }
__host__ __device__ __forceinline__ void stage_rc(int b, int& R, int& C) { const int st = b / 1024, sb = b % 1024, swz = sb ^ (((sb >> 9) & 1) << 5); R = (st >> 1) * 16 + swz / 64; C = (st & 1) * 32 + (swz % 64) / 2; }
__host__ __device__ __forceinline__ int perm32(int rho) { const int n = rho >> 4, i = rho & 15; return 8 * (i >> 2) + 4 * n + (i & 3); }

struct Unit { int pm, pn; };
struct Gemm { const bf16_t* A; const bf16_t* Bt; int M, N, K; };

struct StaticOrder {
    int nM, nN, nwg, G, c;
    __host__ __device__ void init(int M, int N, int G_, int c_) { nM = M / BM; nN = N / BM; nwg = nM * nN; G = G_; c = c_; }
    __host__ __device__ bool next(int i, Unit& u) const {
        const long L = (long)i * G + c; if (L >= nwg) return false;
        int wgid = (int)L; { const int q = nwg / NXCD, r = nwg % NXCD, xcd = wgid % NXCD, off = wgid / NXCD; wgid = (xcd < r ? xcd * (q + 1) : r * (q + 1) + (xcd - r) * q) + off; }
        const int nig = WGM * nN, gid = wgid / nig, fm = gid * WGM, gsz = (nM - fm) < WGM ? (nM - fm) : WGM;
        u.pm = fm + ((wgid % nig) % gsz); u.pn = (wgid % nig) / gsz; return true;
    }
    __device__ __forceinline__ void a_ready(const Unit&) const {}
    __device__ __forceinline__ void done(const Unit&) const {}
};

__device__ __forceinline__ unsigned cvt_pk_bf16(float lo, float hi) { unsigned r; asm volatile("v_cvt_pk_bf16_f32 %0, %1, %2" : "=v"(r) : "v"(lo), "v"(hi)); return r; }
typedef float f32x2 __attribute__((ext_vector_type(2)));

template <class Epi, class Sched, bool ALIGN_EPI = false, bool SP2 = false>
__device__ __forceinline__ void gemm_phase(PG8_LAS unsigned char* lds, const Gemm g, const Sched& S, const Epi& E) {
    const int tid = threadIdx.x, wid = __builtin_amdgcn_readfirstlane(tid >> 6), lane = tid & 63, wr = wid >> 2, wc = wid & 3, fr = lane & 15, fq = lane >> 4;
    const int K = g.K, nt = K / BK;
    unsigned voffA[2], voffB[2];
#pragma unroll
    for (int i = 0; i < 2; ++i) { int R, C; stage_rc(tid * 16 + i * 8192, R, C); const int Rb = Epi::PERM ? ((R & ~31) + perm32(R & 31)) : R;
        voffA[i] = (unsigned)(R * K + C) * 2u; voffB[i] = (unsigned)(Rb * K + C) * 2u; }
    const size_t kstep = (size_t)(BK * 2);
    const size_t hstep = (size_t)HALF * K * 2;
    const size_t tstep = 2 * hstep;
    const unsigned ldsw = (unsigned)wid * 1024u;
    const int aoff = lds_byte(wr * 64 + fr, fq * 8), boff = lds_byte(wc * 32 + fr, fq * 8);
#define PG8_SA(b, h) (((b) * 2 + (h)) * HTB)
#define PG8_SB(b, h) ((4 + (b) * 2 + (h)) * HTB)
#define PG8_STAGE(bufoff, gbase, voff) do { _Pragma("unroll") for (int _i = 0; _i < 2; ++_i) \
        __builtin_amdgcn_global_load_lds((const unsigned*)((const char*)(gbase) + (voff)[_i]), (PG8_LAS unsigned*)(lds + (bufoff) + ldsw + _i * 8192), 16, 0, 0); } while (0)
#define PG8_LDA(dst, b, h) do { _Pragma("unroll") for (int m = 0; m < 4; ++m) _Pragma("unroll") for (int k = 0; k < 2; ++k) dst[m][k] = *(const PG8_LAS bf16x8*)(lds + PG8_SA(b, h) + aoff + m * 2048 + k * 1024); } while (0)
#define PG8_LDB(dst, b, h) do { _Pragma("unroll") for (int n = 0; n < 2; ++n) _Pragma("unroll") for (int k = 0; k < 2; ++k) dst[n][k] = *(const PG8_LAS bf16x8*)(lds + PG8_SB(b, h) + boff + n * 2048 + k * 1024); } while (0)
#define PG8_MMA(ai, bj, At, Bt) do { __builtin_amdgcn_s_setprio(1); _Pragma("unroll") for (int m = 0; m < 4; ++m) _Pragma("unroll") for (int n = 0; n < 2; ++n) _Pragma("unroll") for (int k = 0; k < 2; ++k) \
        acc[ai][bj][m][n] = __builtin_amdgcn_mfma_f32_16x16x32_bf16(Bt[n][k], At[m][k], acc[ai][bj][m][n], 0, 0, 0); __builtin_amdgcn_s_setprio(0); } while (0)
#define PG8_WAIT_V(n) asm volatile("s_waitcnt vmcnt(" #n ")" ::: "memory")
#define PG8_WAIT_L(n) asm volatile("s_waitcnt lgkmcnt(" #n ")" ::: "memory")
#define PG8_BAR __builtin_amdgcn_s_barrier()
#define PG8_SCHED __builtin_amdgcn_sched_barrier(0)
    Unit cur, nxt; int ui = 0;
    if (!S.next(0, cur)) return;
    f32x4 acc[2][2][4][2];
#pragma unroll
    for (int a = 0; a < 2; ++a)
#pragma unroll
        for (int b = 0; b < 2; ++b)
#pragma unroll
            for (int m = 0; m < 4; ++m)
#pragma unroll
                for (int n = 0; n < 2; ++n) acc[a][b][m][n] = (f32x4){0.f, 0.f, 0.f, 0.f};
    bf16x8 At[4][2], B0[2][2], B1[2][2];
    const char* cA = (const char*)g.A + (size_t)cur.pm * tstep; const char* cB = (const char*)g.Bt + (size_t)cur.pn * tstep;
    S.a_ready(cur);
    if constexpr (SP2) {
        PG8_STAGE(PG8_SB(0, 0), cB, voffB); PG8_STAGE(PG8_SB(0, 1), cB + hstep, voffB); PG8_STAGE(PG8_SA(0, 0), cA, voffA); PG8_STAGE(PG8_SA(0, 1), cA + hstep, voffA);
        if (wr == 1) PG8_BAR;
        PG8_WAIT_V(2); PG8_BAR;
        PG8_STAGE(PG8_SB(1, 0), cB + kstep, voffB); PG8_STAGE(PG8_SA(1, 0), cA + kstep, voffA); PG8_STAGE(PG8_SB(1, 1), cB + hstep + kstep, voffB);
        PG8_WAIT_V(6); PG8_BAR;
    } else {
        PG8_STAGE(PG8_SB(0, 0), cB, voffB); PG8_STAGE(PG8_SA(0, 0), cA, voffA); PG8_STAGE(PG8_SB(0, 1), cB + hstep, voffB); PG8_STAGE(PG8_SA(0, 1), cA + hstep, voffA);
        if (wr == 1) PG8_BAR;
        PG8_WAIT_V(4); PG8_BAR;
        PG8_STAGE(PG8_SB(1, 0), cB + kstep, voffB); PG8_STAGE(PG8_SA(1, 0), cA + kstep, voffA); PG8_STAGE(PG8_SB(1, 1), cB + hstep + kstep, voffB);
        PG8_WAIT_V(6); PG8_BAR;
    }
    for (;;) {
        const bool has_next = S.next(ui + 1, nxt);
        const char* nA = has_next ? (const char*)g.A + (size_t)nxt.pm * tstep : cA; const char* nB = has_next ? (const char*)g.Bt + (size_t)nxt.pn * tstep : cB;
        for (int t = 0; t < nt; t += 2) {
            const bool last = (t == nt - 2);
            const char* a1 = cA + (size_t)(t + 1) * kstep;
            const char* a2 = last ? nA : cA + (size_t)(t + 2) * kstep; const char* b2 = last ? nB : cB + (size_t)(t + 2) * kstep;
            const char* a3 = a2 + kstep; const char* b3 = b2 + kstep;
            if (last && has_next) S.a_ready(nxt);
            if constexpr (SP2) {
            PG8_LDB(B0, 0, 0); PG8_LDB(B1, 0, 1); PG8_SCHED; PG8_LDA(At, 0, 0); PG8_STAGE(PG8_SA(1, 1), a1 + hstep, voffA);
            PG8_WAIT_V(8); PG8_WAIT_L(0); PG8_BAR; PG8_MMA(0, 0, At, B0); PG8_MMA(0, 1, At, B1); PG8_BAR; PG8_SCHED;
            PG8_LDA(At, 0, 1); PG8_STAGE(PG8_SB(0, 0), b2, voffB); PG8_STAGE(PG8_SB(0, 1), b2 + hstep, voffB); PG8_STAGE(PG8_SA(0, 0), a2, voffA);
            PG8_WAIT_V(8); PG8_WAIT_L(0); PG8_BAR; PG8_MMA(1, 0, At, B0); PG8_MMA(1, 1, At, B1); PG8_BAR; PG8_SCHED;
            PG8_LDB(B0, 1, 0); PG8_LDB(B1, 1, 1); PG8_SCHED; PG8_LDA(At, 1, 0); PG8_STAGE(PG8_SA(0, 1), a2 + hstep, voffA);
            PG8_WAIT_V(8); PG8_WAIT_L(0); PG8_BAR; PG8_MMA(0, 0, At, B0); PG8_MMA(0, 1, At, B1); PG8_BAR; PG8_SCHED;
            PG8_LDA(At, 1, 1); PG8_STAGE(PG8_SB(1, 0), b3, voffB); PG8_STAGE(PG8_SB(1, 1), b3 + hstep, voffB); PG8_STAGE(PG8_SA(1, 0), a3, voffA);
            PG8_WAIT_V(8); PG8_WAIT_L(0); PG8_BAR; PG8_MMA(1, 0, At, B0); PG8_MMA(1, 1, At, B1); PG8_BAR; PG8_SCHED;
            } else {
            PG8_LDB(B0, 0, 0); PG8_SCHED; PG8_LDA(At, 0, 0); PG8_STAGE(PG8_SA(1, 1), a1 + hstep, voffA);
            PG8_WAIT_L(8); PG8_BAR; PG8_WAIT_L(0); PG8_MMA(0, 0, At, B0); PG8_BAR; PG8_SCHED;
            PG8_LDB(B1, 0, 1); PG8_STAGE(PG8_SB(0, 0), b2, voffB);
            PG8_BAR; PG8_WAIT_L(0); PG8_MMA(0, 1, At, B1); PG8_BAR;
            PG8_LDA(At, 0, 1); PG8_STAGE(PG8_SA(0, 0), a2, voffA);
            PG8_BAR; PG8_WAIT_L(0); PG8_MMA(1, 0, At, B0); PG8_BAR; PG8_SCHED;
            PG8_STAGE(PG8_SB(0, 1), b2 + hstep, voffB);
            PG8_WAIT_V(6); PG8_BAR; PG8_MMA(1, 1, At, B1); PG8_BAR;
            PG8_LDB(B0, 1, 0); PG8_SCHED; PG8_LDA(At, 1, 0); PG8_STAGE(PG8_SA(0, 1), a2 + hstep, voffA);
            PG8_WAIT_L(8); PG8_BAR; PG8_WAIT_L(0); PG8_MMA(0, 0, At, B0); PG8_BAR; PG8_SCHED;
            PG8_LDB(B1, 1, 1); PG8_STAGE(PG8_SB(1, 0), b3, voffB);
            PG8_BAR; PG8_WAIT_L(0); PG8_MMA(0, 1, At, B1); PG8_BAR;
            PG8_LDA(At, 1, 1); PG8_STAGE(PG8_SA(1, 0), a3, voffA);
            PG8_BAR; PG8_WAIT_L(0); PG8_MMA(1, 0, At, B0); PG8_BAR; PG8_SCHED;
            PG8_STAGE(PG8_SB(1, 1), b3 + hstep, voffB);
            PG8_WAIT_V(6); PG8_BAR; PG8_MMA(1, 1, At, B1); PG8_BAR;
            }
        }
        if constexpr (ALIGN_EPI) { if (wr == 0) PG8_BAR; }
        if constexpr (!Epi::AFTER_DRAIN) { E(acc, cur, wr, wc, fr, fq); S.done(cur); }
        if (!has_next) break;
#pragma unroll
        for (int a = 0; a < 2; ++a)
#pragma unroll
            for (int b = 0; b < 2; ++b)
#pragma unroll
                for (int m = 0; m < 4; ++m)
#pragma unroll
                    for (int n = 0; n < 2; ++n) acc[a][b][m][n] = (f32x4){0.f, 0.f, 0.f, 0.f};
        cur = nxt; cA = nA; cB = nB; ++ui;
        if constexpr (ALIGN_EPI) { if (wr == 1) PG8_BAR; }
    }
    PG8_WAIT_V(0);
    if constexpr (!ALIGN_EPI) { if (wr == 0) PG8_BAR; }
    PG8_BAR;
    if constexpr (Epi::AFTER_DRAIN) { E.fused(acc, cur, wr, wc, fr, fq, lds, wid, lane); S.done(cur); }
#undef PG8_SA
#undef PG8_SB
#undef PG8_STAGE
#undef PG8_LDA
#undef PG8_LDB
#undef PG8_MMA
#undef PG8_WAIT_V
#undef PG8_WAIT_L
#undef PG8_BAR
#undef PG8_SCHED
}
}

#ifndef MK_ONE_LAUNCH
#define MK_ONE_LAUNCH 0
#endif
#define LAS __attribute__((address_space(3)))
typedef unsigned short bf16;
typedef float f32x4 __attribute__((ext_vector_type(4)));
typedef unsigned u32x4 __attribute__((ext_vector_type(4)));
typedef unsigned u32x2 __attribute__((ext_vector_type(2)));

constexpr int D = 1024, NTOK = 10240, NPT = 8192, LP = 256, LS = 1024, NSEQ = 34;
constexpr int NPROJ = 3584, NIN = 3600, DFF = 4096;
constexpr int SC_OFF = 0, HY_OFF = 768, ML_OFF = 1536;
constexpr float EPS = 1e-6f;
constexpr size_t MiB = 1u << 20;
constexpr size_t WS_CTL = 0, CTL_BYTES = 65536;
constexpr size_t WS_WIN = 1 * MiB, WS_WOUT = 15 * MiB, WS_W1 = 19 * MiB, WS_W2 = 35 * MiB, WS_MOD = 51 * MiB, WS_FILT = 52 * MiB, WS_GATES = 62 * MiB;
constexpr size_t WS_U = 63 * MiB, WS_Y = 83 * MiB, WS_HF = 103 * MiB, WS_HB = 113 * MiB, WS_PROJ = 123 * MiB, WS_END = 203 * MiB;
constexpr int LDS_BYTES = 147456;
constexpr size_t OUT_YS = 8388608, OUT_C = 10485760, OUT_N = 18874368, OUT_M = 18939904;
constexpr size_t FILT_L = 5 * MiB / 4;

struct Args { const float* in[28]; float* out; unsigned char* ws; int ph_lo, ph_hi; };
typedef const __attribute__((address_space(4))) Args CArgs;
#define PHASE_ARGS() const __attribute__((address_space(4))) Args* ap_ = (const __attribute__((address_space(4))) Args*)__builtin_amdgcn_kernarg_segment_ptr(); asm volatile("" : "+s"(ap_)); CArgs& a = *ap_
enum { I_XP = 0, I_XS, I_SC, I_SN, I_SM, I_C, I_CCTX, I_N1G, I_ADAW, I_ADAB, I_WIN, I_SCW, I_HYCW, I_HW1, I_HB1, I_HW2, I_HB2, I_HW3, I_HFREQ, I_HSKIP, I_MLCW, I_MLGB, I_MLNG, I_WOUT, I_N2G, I_W1, I_W2, I_NFG };

__device__ __forceinline__ unsigned f2bf(float f) { unsigned u = __builtin_bit_cast(unsigned, f); return (u + 0x7fffu + ((u >> 16) & 1u)) >> 16; }
__device__ __forceinline__ unsigned pk2(float lo, float hi) { return f2bf(lo) | (f2bf(hi) << 16); }
__device__ __forceinline__ float bflo(unsigned u) { return __builtin_bit_cast(float, u << 16); }
__device__ __forceinline__ float bfhi(unsigned u) { return __builtin_bit_cast(float, u & 0xffff0000u); }
__device__ __forceinline__ void unpack8(const u32x4 v, float* f) { f[0] = bflo(v.x); f[1] = bfhi(v.x); f[2] = bflo(v.y); f[3] = bfhi(v.y); f[4] = bflo(v.z); f[5] = bfhi(v.z); f[6] = bflo(v.w); f[7] = bfhi(v.w); }
__device__ __forceinline__ u32x4 ld8(const bf16* p) { return *(const u32x4*)p; }
__device__ __forceinline__ float wave_sum(float v) {
#pragma unroll
    for (int o = 1; o < 64; o <<= 1) v += __shfl_xor(v, o);
    return v;
}
__device__ __forceinline__ float silu_f(float x) { return x / (1.f + __expf(-x)); }
__device__ __forceinline__ float sigmoid_f(float x) { return 1.f / (1.f + __expf(-x)); }
__device__ __forceinline__ int tok_kind(int r) { return r < NPT ? 0 : 1 + ((r - NPT) >> 10); }

__device__ __forceinline__ void p0_transpose_item(const float* W, int ldw, int K, int N, bf16* WT, float* scr, int item, int lane) {
    const int nblk = N / 32, kb = item / nblk, nb = item % nblk, k0 = 64 * kb, n0 = 32 * nb;
#pragma unroll 8
    for (int i = 0; i < 32; ++i) { const int kk = 2 * i + (lane >> 5); scr[kk * 33 + (lane & 31)] = W[(size_t)(k0 + kk) * ldw + n0 + (lane & 31)]; }
    asm volatile("s_waitcnt lgkmcnt(0)" ::: "memory");
    const int c = lane & 7;
#pragma unroll
    for (int j = 0; j < 4; ++j) { const int n = (lane >> 3) + 8 * j; const float* s = scr + (8 * c) * 33 + n;
        u32x4 o; o.x = pk2(s[0 * 33], s[1 * 33]); o.y = pk2(s[2 * 33], s[3 * 33]); o.z = pk2(s[4 * 33], s[5 * 33]); o.w = pk2(s[6 * 33], s[7 * 33]);
        *(u32x4*)(WT + (size_t)(n0 + n) * K + k0 + 8 * c) = o; }
    asm volatile("s_waitcnt lgkmcnt(0)" ::: "memory");
}

__device__ __forceinline__ void p0_prologue(CArgs& a, unsigned char* lds) {
    const int tid = threadIdx.x, lane = tid & 63, wave = tid >> 6, G = gridDim.x, bid = blockIdx.x;
    unsigned char* ws = a.ws;
    float* fl = (float*)lds;
    if (bid == 0 && tid < 2) ((unsigned*)(ws + WS_CTL))[64 * (1 + tid)] = 0u;
    bool have_svec = false;
    for (int it = bid; it < 192; it += G) {
        if (!have_svec) {
            for (int i = tid; i < 3 * 1024; i += 512) { const int kind = i >> 10, k = i & 1023; const float v = kind == 0 ? a.in[I_CCTX][k] : a.in[I_C][(kind - 1) * 1024 + k]; fl[i] = silu_f(v); }
            have_svec = true;
        }
        __syncthreads();
        const int l = it / 96, cgp = it % 96;
        const float* W = a.in[I_ADAW] + (size_t)l * 1024 * 6144 + cgp * 64;
        const int c4 = lane & 15, kr = lane >> 4;
        f32x4 acc[3]; acc[0] = acc[1] = acc[2] = (f32x4){0.f, 0.f, 0.f, 0.f};
#pragma unroll 8
        for (int i = 0; i < 32; ++i) { const int k = wave * 128 + 4 * i + kr; const f32x4 w = *(const f32x4*)(W + (size_t)k * 6144 + 4 * c4);
            acc[0] += w * fl[k]; acc[1] += w * fl[1024 + k]; acc[2] += w * fl[2048 + k]; }
#pragma unroll
        for (int kd = 0; kd < 3; ++kd)
#pragma unroll
            for (int e = 0; e < 4; ++e) { float v = acc[kd][e]; v += __shfl_xor(v, 16); v += __shfl_xor(v, 32); acc[kd][e] = v; }
        float* red = fl + 3072;
        if (kr == 0) {
#pragma unroll
            for (int kd = 0; kd < 3; ++kd)
#pragma unroll
                for (int e = 0; e < 4; ++e) red[(wave * 3 + kd) * 64 + 4 * c4 + e] = acc[kd][e];
        }
        __syncthreads();
        if (tid < 192) { const int kd = tid >> 6, c = tid & 63; float s = a.in[I_ADAB][l * 6144 + cgp * 64 + c];
#pragma unroll
            for (int w = 0; w < 8; ++w) s += red[(w * 3 + kd) * 64 + c];
            ((float*)(ws + WS_MOD))[(l * 3 + kd) * 6144 + cgp * 64 + c] = s; }
        __syncthreads();
    }
    __syncthreads();
    for (int it = (G - 1 - bid); it < 160; it += G) {
        const int l = it / 80, r = it % 80, Lsel = r >= 16, mb = Lsel ? r - 16 : r, L = Lsel ? 1024 : 256, m0 = mb * 16;
        float* z = fl;
        float* h1 = fl + 16 * 33;
        float* h2 = h1 + 16 * 64;
        if (tid < 256) { const int mi = tid >> 4, band = (tid & 15) + 1, m = m0 + mi; const int ph = (m * band) % L;
            float sn, cs; sincospif(2.0f * (float)ph / (float)L, &sn, &cs);
            z[mi * 33 + band] = cs; z[mi * 33 + 16 + band] = -sn; if (band == 1) z[mi * 33] = (float)m / (float)(L - 1); }
        __syncthreads();
        const float* w1 = a.in[I_HW1] + l * 33 * 64; const float* w2 = a.in[I_HW2] + l * 64 * 64; const float* w3 = a.in[I_HW3] + (size_t)l * 64 * 1024;
        { const int j = tid & 63; const float fj = a.in[I_HFREQ][l * 64 + j], bj = a.in[I_HB1][l * 64 + j];
#pragma unroll
          for (int h = 0; h < 2; ++h) { const int mi = (tid >> 6) + 8 * h; float d = bj; for (int k = 0; k < 33; ++k) d += z[mi * 33 + k] * w1[k * 64 + j]; h1[mi * 64 + j] = sinf(fj * d); } }
        __syncthreads();
        { const int j = tid & 63; const float fj = a.in[I_HFREQ][l * 64 + j], bj = a.in[I_HB2][l * 64 + j];
#pragma unroll
          for (int h = 0; h < 2; ++h) { const int mi = (tid >> 6) + 8 * h; float d = bj; for (int k = 0; k < 64; ++k) d += h1[mi * 64 + k] * w2[k * 64 + j]; h2[mi * 64 + j] = sinf(fj * d); } }
        __syncthreads();
        float* Gf = (float*)(ws + WS_FILT) + (size_t)l * FILT_L + (Lsel ? 262144 : 0);
#pragma unroll 1
        for (int h = 0; h < 2; ++h) { const int col = 64 * (wave + 8 * h) + lane, o = col >> 9, dd = (col >> 8) & 1, c = col & 255;
            float acc[16];
#pragma unroll
            for (int mi = 0; mi < 16; ++mi) acc[mi] = 0.f;
            for (int k = 0; k < 64; ++k) { const float w = w3[k * 1024 + col];
#pragma unroll
                for (int mi = 0; mi < 16; ++mi) acc[mi] += h2[mi * 64 + k] * w; }
            const float la = logf(1e-2f) / 1.5f, lb = logf(1e-2f) / 0.3f; const float delta = fabsf(la + (float)c * ((lb - la) / 255.0f));
            float* gp = Gf + (size_t)(o * 256 + c) * (2 * L) + L;
#pragma unroll
            for (int mi = 0; mi < 16; ++mi) { const int m = m0 + mi; const float t = (float)m / (float)(L - 1); const float v = acc[mi] * expf(-t * delta);
                if (dd == 0) gp[m] = v; else if (m > 0) gp[-m] = v; } }
        __syncthreads();
    }
    __syncthreads();
    {
        float* scr = fl + wave * 4096;
        const int gw = bid * 8 + wave, NGW = G * 8;
        constexpr int I_IN = 16 * 112, I_O = 16 * 32, I_1 = 16 * 128, I_2 = 64 * 32, PER = I_IN + I_O + I_1 + I_2;
        for (int it = gw; it < 2 * PER; it += NGW) {
            const int l = it / PER; int r = it % PER;
            if (r < I_IN) { p0_transpose_item(a.in[I_WIN] + (size_t)l * 1024 * NIN, NIN, 1024, NPROJ, (bf16*)(ws + WS_WIN) + (size_t)l * NPROJ * 1024, scr, r, lane); continue; } r -= I_IN;
            if (r < I_O) { p0_transpose_item(a.in[I_WOUT] + (size_t)l * 1024 * 1024, 1024, 1024, 1024, (bf16*)(ws + WS_WOUT) + (size_t)l * 1024 * 1024, scr, r, lane); continue; } r -= I_O;
            if (r < I_1) { p0_transpose_item(a.in[I_W1] + (size_t)l * 1024 * DFF, DFF, 1024, DFF, (bf16*)(ws + WS_W1) + (size_t)l * DFF * 1024, scr, r, lane); continue; } r -= I_1;
            p0_transpose_item(a.in[I_W2] + (size_t)l * DFF * 1024, 1024, DFF, 1024, (bf16*)(ws + WS_W2) + (size_t)l * 1024 * DFF, scr, r, lane);
        }
    }
}

template <int MODE, bool GATES, bool FINAL>
__device__ __forceinline__ void norm_phase(CArgs& a, unsigned char* lds, int l, int which) {
    const int tid = threadIdx.x, lane = tid & 63, wave = tid >> 6, G = gridDim.x, bid = blockIdx.x;
    float* X = a.out; bf16* U = (bf16*)(a.ws + WS_U); float* GT = (float*)(a.ws + WS_GATES);
    const float* mod = (const float*)(a.ws + WS_MOD) + (size_t)l * 3 * 6144;
    float* wg = (float*)lds;
    if (GATES) {
        const float* W = a.in[I_WIN] + (size_t)l * 1024 * NIN + NPROJ;
        for (int i = tid; i < 4096; i += 512) { const int k = i >> 2, j4 = i & 3; const f32x4 v = *(const f32x4*)(W + (size_t)k * NIN + 4 * j4);
            wg[(4 * j4 + 0) * 1024 + k] = v.x; wg[(4 * j4 + 1) * 1024 + k] = v.y; wg[(4 * j4 + 2) * 1024 + k] = v.z; wg[(4 * j4 + 3) * 1024 + k] = v.w; }
        __syncthreads();
    }
    const float* gvec = FINAL ? a.in[I_NFG] : (which == 1 ? a.in[I_N1G] + l * 1024 : a.in[I_N2G] + l * 1024);
    for (int r = bid * 8 + wave; r < NTOK; r += G * 8) {
        f32x4 v[4];
        if (MODE == 0) {
            const float* src = r < NPT ? a.in[I_XP] + (size_t)r * D : a.in[I_XS] + (size_t)(r - NPT) * D;
#pragma unroll
            for (int j = 0; j < 4; ++j) v[j] = *(const f32x4*)(src + 4 * lane + 256 * j);
            if (r >= NPT) { const int t = (r - NPT) & 1023; const float pr = (float)(t >> 6), pc = (float)(t & 63);
#pragma unroll
                for (int j = 0; j < 4; ++j) { const float p = (j < 2) ? pr : pc;
#pragma unroll
                    for (int e = 0; e < 4; ++e) { const int i = 4 * lane + e; const float om = 1.0f / powf(10000.0f, (float)i / 256.0f); float sn, cs; sincosf(p * om, &sn, &cs); v[j][e] += (j & 1) ? cs : sn; } } }
#pragma unroll
            for (int j = 0; j < 4; ++j) *(f32x4*)(X + (size_t)r * D + 4 * lane + 256 * j) = v[j];
        } else {
#pragma unroll
            for (int j = 0; j < 4; ++j) v[j] = *(const f32x4*)(X + (size_t)r * D + 4 * lane + 256 * j);
        }
        float ss = 0.f;
#pragma unroll
        for (int j = 0; j < 4; ++j) ss += (v[j].x * v[j].x + v[j].y * v[j].y) + (v[j].z * v[j].z + v[j].w * v[j].w);
        const float rstd = 1.0f / sqrtf(wave_sum(ss) * (1.0f / D) + EPS);
        if (FINAL) {
#pragma unroll
            for (int j = 0; j < 4; ++j) { const f32x4 g = *(const f32x4*)(gvec + 4 * lane + 256 * j); *(f32x4*)(X + (size_t)r * D + 4 * lane + 256 * j) = v[j] * rstd * g; }
            continue;
        }
        const int kind = tok_kind(r);
        const float* sh = mod + kind * 6144 + (which == 1 ? 0 : 3072); const float* sc = sh + 1024;
#pragma unroll
        for (int j = 0; j < 4; ++j) { const int c = 4 * lane + 256 * j; const f32x4 g = *(const f32x4*)(gvec + c), s1 = *(const f32x4*)(sc + c), s0 = *(const f32x4*)(sh + c);
            v[j] = v[j] * rstd * g * (s1 + 1.0f) + s0;
            u32x2 o; o.x = pk2(v[j].x, v[j].y); o.y = pk2(v[j].z, v[j].w); *(u32x2*)(U + (size_t)r * D + c) = o; }
        if (GATES) {
            float myg = 0.f;
#pragma unroll 4
            for (int g = 0; g < 16; ++g) { float p = 0.f;
#pragma unroll
                for (int j = 0; j < 4; ++j) { const f32x4 w = *(const f32x4*)(wg + g * 1024 + 4 * lane + 256 * j); p += (v[j].x * w.x + v[j].y * w.y) + (v[j].z * w.z + v[j].w * w.w); }
                p = wave_sum(p); if (lane == g) myg = p; }
            if (lane < 16) GT[(size_t)r * 16 + lane] = myg + a.in[I_MLGB][l * 16 + lane];
        }
    }
}

template <int ACT> struct EpiBf16 {
    static constexpr bool PERM = true, AFTER_DRAIN = false;
    bf16* O; int ldc;
    __device__ __forceinline__ void operator()(const pg8::f32x4 (&acc)[2][2][4][2], const pg8::Unit& u, int wr, int wc, int fr, int fq) const {
        const int row0 = u.pm * 256 + wr * 64 + fr, col0 = u.pn * 256 + wc * 32 + 8 * fq;
#pragma unroll
        for (int ai = 0; ai < 2; ++ai)
#pragma unroll
            for (int m = 0; m < 4; ++m) { bf16* rowp = O + (size_t)(row0 + ai * 128 + m * 16) * ldc + col0;
#pragma unroll
                for (int bj = 0; bj < 2; ++bj) { pg8::f32x4 v0 = acc[ai][bj][m][0], v1 = acc[ai][bj][m][1];
                    if (ACT == 1) {
#pragma unroll
                        for (int e = 0; e < 4; ++e) { const float p = fmaxf(v0[e], 0.f), q = fmaxf(v1[e], 0.f); v0[e] = p * p; v1[e] = q * q; } }
                    u32x4 w; w.x = pg8::cvt_pk_bf16(v0[0], v0[1]); w.y = pg8::cvt_pk_bf16(v0[2], v0[3]); w.z = pg8::cvt_pk_bf16(v1[0], v1[1]); w.w = pg8::cvt_pk_bf16(v1[2], v1[3]);
                    *(u32x4*)(rowp + bj * 128) = w; } }
    }
};
struct EpiResid {
    static constexpr bool PERM = false, AFTER_DRAIN = false;
    float* X; const float* gate;
    __device__ __forceinline__ void operator()(const pg8::f32x4 (&acc)[2][2][4][2], const pg8::Unit& u, int wr, int wc, int fr, int fq) const {
        const int row0 = u.pm * 256 + wr * 64 + fr, col0 = u.pn * 256 + wc * 32 + 4 * fq;
        const int kind = u.pm < 32 ? 0 : 1 + ((u.pm - 32) >> 2);
        pg8::f32x4 gv[2][2];
#pragma unroll
        for (int bj = 0; bj < 2; ++bj)
#pragma unroll
            for (int n = 0; n < 2; ++n) gv[bj][n] = *(const pg8::f32x4*)(gate + kind * 6144 + col0 + bj * 128 + n * 16);
#pragma unroll
        for (int ai = 0; ai < 2; ++ai)
#pragma unroll
            for (int m = 0; m < 4; ++m) { float* rowp = X + (size_t)(row0 + ai * 128 + m * 16) * D + col0;
#pragma unroll
                for (int bj = 0; bj < 2; ++bj)
#pragma unroll
                    for (int n = 0; n < 2; ++n) { pg8::f32x4* p = (pg8::f32x4*)(rowp + bj * 128 + n * 16); *p = *p + gv[bj][n] * acc[ai][bj][m][n]; } }
    }
};

__device__ __forceinline__ float conv3_at(const bf16* base, int ld, int t, int L, int col, float w0, float w1, float w2) {
    float r = w1 * bflo(base[(size_t)t * ld + col]);
    if (t > 0) r += w0 * bflo(base[(size_t)(t - 1) * ld + col]);
    if (t < L - 1) r += w2 * bflo(base[(size_t)(t + 1) * ld + col]);
    return r;
}

__device__ __forceinline__ void sc_item(CArgs& a, int l, int item) {
    const bf16* P = (const bf16*)(a.ws + WS_PROJ); bf16* Y = (bf16*)(a.ws + WS_Y);
    const int idx = item * 512 + threadIdx.x;
    const int tok = idx >> 5, c0 = (idx & 31) * 8;
    const int t = tok < NPT ? (tok & 255) : ((tok - NPT) & 1023), L = tok < NPT ? LP : LS;
    const float* w = a.in[I_SCW] + l * 3 * 256;
    float bg[8], cx[3][8];
    unpack8(ld8(P + (size_t)tok * NPROJ + c0), bg);
#pragma unroll
    for (int j = 0; j < 3; ++j) { const int tt = t + j - 1;
        if (tt >= 0 && tt < L) { float cgv[8], xi[8]; unpack8(ld8(P + (size_t)(tok + j - 1) * NPROJ + 256 + c0), cgv); unpack8(ld8(P + (size_t)(tok + j - 1) * NPROJ + 512 + c0), xi);
#pragma unroll
            for (int e = 0; e < 8; ++e) cx[j][e] = cgv[e] * xi[e]; }
        else {
#pragma unroll
            for (int e = 0; e < 8; ++e) cx[j][e] = 0.f; } }
    float y[8];
#pragma unroll
    for (int e = 0; e < 8; ++e) y[e] = bg[e] * (w[c0 + e] * cx[0][e] + w[256 + c0 + e] * cx[1][e] + w[512 + c0 + e] * cx[2][e]);
    u32x4 o; o.x = pk2(y[0], y[1]); o.y = pk2(y[2], y[3]); o.z = pk2(y[4], y[5]); o.w = pk2(y[6], y[7]);
    *(u32x4*)(Y + (size_t)tok * D + c0) = o;
}

__device__ __forceinline__ void hyena_item_naive(CArgs& a, unsigned char* lds, int l, int item) {
    const int tid = threadIdx.x;
    int seq, cgi, CG, L;
    if (item < 64) { seq = 32 + item / 32; cgi = item % 32; CG = 8; L = LS; } else { const int it = item - 64; seq = it / 8; cgi = it % 8; CG = 32; L = LP; }
    const int tok0 = seq < 32 ? seq * 256 : NPT + (seq - 32) * 1024, c0 = cgi * CG, FS = 2 * L + 1;
    float* Fs = (float*)lds;
    float* zin = (float*)(lds + 66048);
    float* zout = (float*)(lds + 66048 + 32768);
    float* nrm = (float*)(lds + 66048 + 65536);
    const bf16* P = (const bf16*)(a.ws + WS_PROJ) + (size_t)tok0 * NPROJ + HY_OFF; bf16* Y = (bf16*)(a.ws + WS_Y);
    const float* cw = a.in[I_HYCW] + l * 3 * 768;
    const float* Gf = (const float*)(a.ws + WS_FILT) + (size_t)l * FILT_L + (L == LS ? 262144 : 0);
    const int c = tid % CG, tb = tid / CG, t0 = tb * 16, ch = c0 + c;
    __syncthreads();
    for (int i = tid; i < L * CG; i += 512) { const int s = i / CG, cc = i % CG, chh = c0 + cc; zin[i] = conv3_at(P, NPROJ, s, L, chh, cw[chh], cw[768 + chh], cw[1536 + chh]); }
#pragma unroll 1
    for (int o = 0; o < 2; ++o) {
        for (int i = tid; i < CG * 2 * L; i += 512) { const int cc = i / (2 * L), j = i % (2 * L); Fs[cc * FS + j] = (j == 0) ? 0.f : Gf[(size_t)(o * 256 + c0 + cc) * (2 * L) + j]; }
        __syncthreads();
        for (int cc = (tid >> 6); cc < CG; cc += 8) { float sa = 0.f; for (int j = (tid & 63); j < 2 * L; j += 64) sa += fabsf(Fs[cc * FS + j]); sa = wave_sum(sa); if ((tid & 63) == 0) nrm[cc] = sa; }
        __syncthreads();
        float acc[16];
#pragma unroll
        for (int i = 0; i < 16; ++i) acc[i] = 0.f;
        const float* Fc = Fs + c * FS + L + t0;
        for (int s0 = 0; s0 < L; s0 += 16) {
            float fw[31];
#pragma unroll
            for (int e = 0; e < 31; ++e) fw[e] = Fc[-s0 - 15 + e];
#pragma unroll
            for (int j = 0; j < 16; ++j) { const float zv = zin[(s0 + j) * CG + c];
#pragma unroll
                for (int i = 0; i < 16; ++i) acc[i] += fw[15 + i - j] * zv; }
        }
        const float inv = 1.0f / nrm[c], sk = a.in[I_HSKIP][l * 512 + o * 256 + ch];
        const int gch = 256 * (o + 1) + ch;
#pragma unroll
        for (int i = 0; i < 16; ++i) zout[(t0 + i) * CG + c] = acc[i] * inv;
#pragma unroll 1
        for (int i = 0; i < 16; ++i) { const int t = t0 + i;
            const float gate = conv3_at(P, NPROJ, t, L, gch, cw[gch], cw[768 + gch], cw[1536 + gch]);
            const float zn = gate * (zout[t * CG + c] + sk * zin[t * CG + c]);
            if (o == 0) zout[t * CG + c] = zn; else Y[(size_t)(tok0 + t) * D + 256 + ch] = (bf16)f2bf(zn); }
        __syncthreads();
        float* tmp = zin; zin = zout; zout = tmp;
    }
}

__device__ __forceinline__ void mlstm_item_naive(CArgs& a, unsigned char* lds, int l, int item) {
    const int tid = threadIdx.x, lane = tid & 63, wave = tid >> 6;
    int seq, hd;
    if (item < 16) { seq = 32 + item / 8; hd = item % 8; } else { const int it = item - 16; seq = it / 8; hd = it % 8; }
    const int head = hd >> 1, dir = hd & 1, L = seq < 32 ? LP : LS, tok0 = seq < 32 ? seq * 256 : NPT + (seq - 32) * 1024;
    float* qs = (float*)lds;
    float* ks = qs + 8192; float* vs = ks + 8192;
    float* part = vs + 8192;
    float* fdv = part + 4096; float* iev = fdv + 64; float* emv = iev + 64; float* dpart = emv + 128;
    const bf16* P = (const bf16*)(a.ws + WS_PROJ) + (size_t)tok0 * NPROJ + ML_OFF;
    const float* GT = (const float*)(a.ws + WS_GATES) + (size_t)tok0 * 16;
    bf16* HO = (bf16*)(a.ws + (dir ? WS_HB : WS_HF)) + (size_t)tok0 * 512 + head * 128;
    const float* cw = a.in[I_MLCW] + l * 3 * 1024;
    const int dv = tid & 127, dkq = tid >> 7;
    float C[32]; float nown = 0.f, mprev = 0.f;
    if (seq >= 32) { const int b = seq - 32; const size_t sidx = (((size_t)b * 2 + l) * 2 + dir) * 4 + head;
        const float* C0 = a.in[I_SC] + sidx * 16384;
#pragma unroll
        for (int e = 0; e < 32; ++e) C[e] = C0[(size_t)(dkq * 32 + e) * 128 + dv];
        if (dv < 32) nown = a.in[I_SN][sidx * 128 + dkq * 32 + dv];
        mprev = a.in[I_SM][sidx]; }
    else {
#pragma unroll
        for (int e = 0; e < 32; ++e) C[e] = 0.f; }
    const float kscale = 0.08838834764831845f;
    for (int ci = 0; ci < L / 64; ++ci) {
        __syncthreads();
#pragma unroll 1
        for (int i = tid; i < 1024; i += 512) { const int j = i >> 4, g8 = (i & 15) * 8; const int p = ci * 64 + j, t = dir ? (L - 1 - p) : p;
            float qa[8], ka[8], va[8];
#pragma unroll
            for (int e = 0; e < 8; ++e) { qa[e] = 0.f; ka[e] = 0.f; }
#pragma unroll
            for (int jj = 0; jj < 3; ++jj) { const int tt = t + jj - 1; if (tt < 0 || tt >= L) continue;
                float qr[8], kr[8]; unpack8(ld8(P + (size_t)tt * NPROJ + head * 128 + g8), qr); unpack8(ld8(P + (size_t)tt * NPROJ + 512 + head * 128 + g8), kr);
#pragma unroll
                for (int e = 0; e < 8; ++e) { qa[e] += cw[jj * 1024 + head * 128 + g8 + e] * qr[e]; ka[e] += cw[jj * 1024 + 512 + head * 128 + g8 + e] * kr[e]; } }
            unpack8(ld8(P + (size_t)t * NPROJ + 1024 + head * 128 + g8), va);
#pragma unroll
            for (int e = 0; e < 8; ++e) { qs[j * 128 + g8 + e] = silu_f(qa[e]); ks[j * 128 + g8 + e] = silu_f(ka[e]) * kscale; vs[j * 128 + g8 + e] = va[e]; } }
        if (wave == 0) { const int p = ci * 64 + lane, t = dir ? (L - 1 - p) : p;
            const float ip = GT[(size_t)t * 16 + dir * 8 + head], fp = GT[(size_t)t * 16 + dir * 8 + 4 + head];
            const float lf = fminf(fp, 0.f) - log1pf(expf(-fabsf(fp)));
            float b = lf;
#pragma unroll
            for (int o = 1; o < 64; o <<= 1) { const float x = __shfl_up(b, o); if (lane >= o) b += x; }
            const float av = ip - b; float cm = av;
#pragma unroll
            for (int o = 1; o < 64; o <<= 1) { const float x = __shfl_up(cm, o); if (lane >= o) cm = fmaxf(cm, x); }
            const float Mj = fmaxf(mprev, cm), mj = b + Mj;
            float mjm1 = __shfl_up(mj, 1); if (lane == 0) mjm1 = mprev;
            fdv[lane] = expf(lf + mjm1 - mj); iev[lane] = expf(ip - mj); emv[lane] = expf(-mj);
            if (lane == 63) emv[64] = mj;
        }
        __syncthreads();
        mprev = emv[64];
#pragma unroll 1
        for (int sb = 0; sb < 8; ++sb) {
#pragma unroll 1
            for (int jj = 0; jj < 8; ++jj) { const int j = sb * 8 + jj; const float fd = fdv[j], ie = iev[j]; const float vi = ie * vs[j * 128 + dv];
                float pr = 0.f;
#pragma unroll
                for (int e = 0; e < 32; ++e) { C[e] = C[e] * fd + ks[j * 128 + dkq * 32 + e] * vi; pr += C[e] * qs[j * 128 + dkq * 32 + e]; }
                part[(jj * 4 + dkq) * 128 + dv] = pr;
                float pd = 0.f;
                if (dv < 32) { nown = nown * fd + ie * ks[j * 128 + dkq * 32 + dv]; pd = nown * qs[j * 128 + dkq * 32 + dv]; }
                if ((wave & 1) == 0) {
#pragma unroll
                    for (int o = 16; o >= 1; o >>= 1) pd += __shfl_xor(pd, o);
                    if (lane == 0) dpart[jj * 4 + dkq] = pd; } }
            __syncthreads();
#pragma unroll
            for (int h = 0; h < 2; ++h) { const int idx = tid + 512 * h, jj = idx >> 7, d2 = idx & 127, j = sb * 8 + jj; const int p = ci * 64 + j, t = dir ? (L - 1 - p) : p;
                const float num = (part[(jj * 4 + 0) * 128 + d2] + part[(jj * 4 + 1) * 128 + d2]) + (part[(jj * 4 + 2) * 128 + d2] + part[(jj * 4 + 3) * 128 + d2]);
                const float den = (dpart[jj * 4 + 0] + dpart[jj * 4 + 1]) + (dpart[jj * 4 + 2] + dpart[jj * 4 + 3]);
                HO[(size_t)t * 512 + d2] = (bf16)f2bf(num / fmaxf(fabsf(den), emv[j])); }
            __syncthreads();
        }
    }
    if (seq < 32) { const size_t sidx = (((size_t)seq * 2 + l) * 2 + dir) * 4 + head;
        float* Co = a.out + OUT_C + sidx * 16384;
#pragma unroll
        for (int e = 0; e < 32; ++e) Co[(size_t)(dkq * 32 + e) * 128 + dv] = C[e];
        if (dv < 32) a.out[OUT_N + sidx * 128 + dkq * 32 + dv] = nown;
        if (tid == 0) a.out[OUT_M + sidx] = mprev; }
}

__device__ __forceinline__ void mixer_phase(CArgs& a, unsigned char* lds, int l) {
    unsigned* ctr = (unsigned*)(a.ws + WS_CTL) + 64 * (1 + l);
    volatile unsigned* slot = (volatile unsigned*)(lds + LDS_BYTES - 64);
    constexpr int N_ML = 272, N_HY = 320, N_SC = 640;
    for (;;) {
        __syncthreads();
        if (threadIdx.x == 0) *slot = atomicAdd(ctr, 1u);
        __syncthreads();
        const int it = (int)*slot;
        if (it >= N_ML + N_HY + N_SC) break;
        int kind, sub;
        if (it < 16) { kind = 0; sub = it; } else if (it < 80) { kind = 1; sub = it - 16; } else if (it < 336) { kind = 0; sub = it - 80 + 16; } else if (it < 592) { kind = 1; sub = it - 336 + 64; } else { kind = 2; sub = it - 592; }
        if (kind == 0) mlstm_item_naive(a, lds, l, sub);
        else if (kind == 1) hyena_item_naive(a, lds, l, sub);
        else sc_item(a, l, sub);
    }
}

__device__ __forceinline__ void combine_phase(CArgs& a, int l) {
    const int tid = threadIdx.x, lane = tid & 63, wave = tid >> 6;
    const bf16* HF = (const bf16*)(a.ws + WS_HF); const bf16* HB = (const bf16*)(a.ws + WS_HB); const bf16* P = (const bf16*)(a.ws + WS_PROJ); bf16* Y = (bf16*)(a.ws + WS_Y);
    const float* ng = a.in[I_MLNG] + l * 512;
    for (int r = blockIdx.x * 8 + wave; r < NTOK; r += gridDim.x * 8) {
        float hf[8], hb[8], ov[8], h[8];
        unpack8(ld8(HF + (size_t)r * 512 + 8 * lane), hf); unpack8(ld8(HB + (size_t)r * 512 + 8 * lane), hb); unpack8(ld8(P + (size_t)r * NPROJ + ML_OFF + 1536 + 8 * lane), ov);
        float ss = 0.f;
#pragma unroll
        for (int e = 0; e < 8; ++e) { h[e] = hf[e] + hb[e]; ss += h[e] * h[e]; }
        ss += __shfl_xor(ss, 1); ss += __shfl_xor(ss, 2); ss += __shfl_xor(ss, 4); ss += __shfl_xor(ss, 8);
        const float rstd = 1.0f / sqrtf(ss * (1.0f / 128.0f) + EPS);
#pragma unroll
        for (int e = 0; e < 8; ++e) h[e] = h[e] * rstd * ng[8 * lane + e] * sigmoid_f(ov[e]);
        u32x4 o; o.x = pk2(h[0], h[1]); o.y = pk2(h[2], h[3]); o.z = pk2(h[4], h[5]); o.w = pk2(h[6], h[7]);
        *(u32x4*)(Y + (size_t)r * D + 512 + 8 * lane) = o;
    }
}

constexpr int N_PHASES = 18;
#define LAYER_PHASES(l, pb) do { \
        if (IN(pb)) { PHASE_ARGS(); if (l == 0) norm_phase<0, true, false>(a, lds, l, 1); else norm_phase<1, true, false>(a, lds, l, 1); } SEAM(pb); \
        if (IN(pb + 1)) {   \
            PHASE_ARGS(); unsigned char* ws = a.ws; \
            pg8::Gemm g{(const bf16*)(ws + WS_U), (const bf16*)(ws + WS_WIN) + (size_t)l * NPROJ * 1024, NTOK, NPROJ, 1024}; pg8::StaticOrder S; S.init(NTOK, NPROJ, G, (int)blockIdx.x); \
            EpiBf16<0> E{(bf16*)(ws + WS_PROJ), NPROJ}; \
            pg8::gemm_phase<EpiBf16<0>, pg8::StaticOrder, true, true>((PG8_LAS unsigned char*)lds, g, S, E); \
        } SEAM(pb + 1); \
        if (IN(pb + 2)) { PHASE_ARGS(); mixer_phase(a, lds, l); } SEAM(pb + 2); \
        if (IN(pb + 3)) { PHASE_ARGS(); combine_phase(a, l); } SEAM(pb + 3); \
        if (IN(pb + 4)) {   \
            PHASE_ARGS(); unsigned char* ws = a.ws; const float* mod = (const float*)(ws + WS_MOD) + (size_t)l * 3 * 6144; \
            pg8::Gemm g{(const bf16*)(ws + WS_Y), (const bf16*)(ws + WS_WOUT) + (size_t)l * 1024 * 1024, NTOK, 1024, 1024}; pg8::StaticOrder S; S.init(NTOK, 1024, G, (int)blockIdx.x); \
            EpiResid E{a.out, mod + 2048}; \
            pg8::gemm_phase<EpiResid, pg8::StaticOrder, true, true>((PG8_LAS unsigned char*)lds, g, S, E); \
        } SEAM(pb + 4); \
        if (IN(pb + 5)) { PHASE_ARGS(); norm_phase<1, false, false>(a, lds, l, 2); } SEAM(pb + 5); \
        if (IN(pb + 6)) {   \
            PHASE_ARGS(); unsigned char* ws = a.ws; \
            pg8::Gemm g{(const bf16*)(ws + WS_U), (const bf16*)(ws + WS_W1) + (size_t)l * DFF * 1024, NTOK, DFF, 1024}; pg8::StaticOrder S; S.init(NTOK, DFF, G, (int)blockIdx.x); \
            EpiBf16<1> E{(bf16*)(ws + WS_PROJ), DFF}; \
            pg8::gemm_phase<EpiBf16<1>, pg8::StaticOrder, true, true>((PG8_LAS unsigned char*)lds, g, S, E); \
        } SEAM(pb + 6); \
        if (IN(pb + 7)) {   \
            PHASE_ARGS(); unsigned char* ws = a.ws; const float* mod = (const float*)(ws + WS_MOD) + (size_t)l * 3 * 6144; \
            pg8::Gemm g{(const bf16*)(ws + WS_PROJ), (const bf16*)(ws + WS_W2) + (size_t)l * 1024 * DFF, NTOK, 1024, DFF}; pg8::StaticOrder S; S.init(NTOK, 1024, G, (int)blockIdx.x); \
            EpiResid E{a.out, mod + 5120}; \
            pg8::gemm_phase<EpiResid, pg8::StaticOrder, true, true>((PG8_LAS unsigned char*)lds, g, S, E); \
        } SEAM(pb + 7); \
    } while (0)

__global__ void __launch_bounds__(512, 2) mk_fwd(Args a_) {
    extern __shared__ __attribute__((aligned(16))) unsigned char lds[];
    cg::grid_group grid = cg::this_grid();
    const int lo = a_.ph_lo, hi = a_.ph_hi;
    const int G = gridDim.x;
#define IN(k) (lo <= (k) && (k) < hi)
#define SEAM(k) do { if (IN(k) && IN((k) + 1)) grid.sync(); } while (0)
    if (IN(0)) { PHASE_ARGS(); p0_prologue(a, lds); } SEAM(0);
    LAYER_PHASES(0, 1);
    LAYER_PHASES(1, 9);
    SEAM(16);
    if (IN(17)) { PHASE_ARGS(); norm_phase<1, false, true>(a, lds, 0, 0); }
#undef IN
#undef SEAM
}


#ifdef DBG_STOP
__global__ void dbg_dump(const unsigned short* buf, size_t n16, float* out, int mode) {
    const size_t cap = mode == 2 ? 8388608 : 10485760, base = mode == 2 ? OUT_C : 0;
    const size_t n = n16 / DBG_E < cap ? n16 / DBG_E : cap;
    for (size_t i = (size_t)blockIdx.x * blockDim.x + threadIdx.x; i < cap; i += (size_t)gridDim.x * blockDim.x) {
        float v = 1.f;
        if (i < n) { v = 0.f; for (int e = 0; e < DBG_E; ++e) v += bflo(buf[DBG_E * i + e]); }
        out[base + i] = v;
    }
}
#endif

#ifdef DBG2_K
__global__ void dbg2_cmp(const unsigned* a, const unsigned* b, size_t nwords, int isf32, unsigned* res) {
    unsigned cnt = 0; float mx = 0.f;
    for (size_t i = (size_t)blockIdx.x * blockDim.x + threadIdx.x; i < nwords; i += (size_t)gridDim.x * blockDim.x) {
        const unsigned x = a[i], y = b[i];
        if (x != y) { ++cnt; float d;
            if (isf32) d = fabsf(__builtin_bit_cast(float, x) - __builtin_bit_cast(float, y));
            else d = fmaxf(fabsf(bflo(x & 0xffffu) - bflo(y & 0xffffu)), fabsf(bfhi(x) - bfhi(y)));
            if (!(d == d)) d = 1e30f; mx = fmaxf(mx, d); } }
    if (cnt) { atomicAdd(res, cnt); atomicMax(res + 1, __builtin_bit_cast(unsigned, mx)); }
}
__global__ void dbg2_fill(const unsigned* res, float* out, size_t n) {
    const unsigned cnt = res[0]; const float mx = __builtin_bit_cast(float, res[1]);
    float V;
    if (cnt == 0) V = 5e35f;
    else { const float mant = 1.0f + log10f((float)cnt); int e = (int)floorf(log10f(fmaxf(mx, 1e-12f))); if (e < -12) e = -12; if (e > 12) e = 12; V = mant * powf(10.f, (float)(20 + e)); }
    for (size_t i = (size_t)blockIdx.x * blockDim.x + threadIdx.x; i < n; i += (size_t)gridDim.x * blockDim.x) out[i] = V;
}
#endif
extern "C" void kernel_launch(void* const* d_in, const int* in_sizes, int n_in, void* d_out, int out_size, void* d_ws, size_t ws_size, hipStream_t stream) {
    static int grid = 0;
    if (grid == 0) {
        if (n_in != 28 || ws_size < WS_END) { fprintf(stderr, "kernel_launch: unexpected n_in %d / ws_size %zu\n", n_in, ws_size); grid = -1; return; }
        int dev = 0, cus = 0, per_cu = 0;
        (void)hipGetDevice(&dev); (void)hipDeviceGetAttribute(&cus, hipDeviceAttributeMultiprocessorCount, dev);
        if (hipFuncSetAttribute((const void*)mk_fwd, hipFuncAttributeMaxDynamicSharedMemorySize, LDS_BYTES) != hipSuccess) { fprintf(stderr, "kernel_launch: hipFuncSetAttribute failed\n"); grid = -1; return; }
        if (hipOccupancyMaxActiveBlocksPerMultiprocessor(&per_cu, (const void*)mk_fwd, 512, LDS_BYTES) != hipSuccess || per_cu < 1) { fprintf(stderr, "kernel_launch: occupancy query says %d\n", per_cu); per_cu = 1; }
        (void)hipGetLastError();
        grid = cus * 1;
        fprintf(stderr, "kernel_launch: cus %d per_cu %d grid %d ws %zu\n", cus, per_cu, grid, ws_size);
    }
    if (grid < 0) return;
    Args a{};
    for (int i = 0; i < 28; ++i) a.in[i] = (const float*)d_in[i];
    a.out = (float*)d_out; a.ws = (unsigned char*)d_ws;
#if MK_ONE_LAUNCH
    a.ph_lo = 0; a.ph_hi = N_PHASES;
    void* args[] = {&a};
    hipError_t e = hipLaunchCooperativeKernel((const void*)mk_fwd, dim3(grid), dim3(512), args, LDS_BYTES, stream);
    if (e != hipSuccess) fprintf(stderr, "kernel_launch: cooperative launch failed: %s\n", hipGetErrorString(e));
#else
#ifdef DBG2_K
    (void)hipMemsetAsync((char*)d_ws + (250u << 20), 0, 256, stream);
    for (int rep = 0; rep < 2; ++rep) {
        for (int p = 0; p < DBG2_K; ++p) { a.ph_lo = p; a.ph_hi = p + 1; hipLaunchKernelGGL(mk_fwd, dim3(grid), dim3(512), LDS_BYTES, stream, a); }
        if (rep == 0) (void)hipMemcpyAsync((char*)d_ws + (208u << 20), DBG2_SRC, (size_t)(DBG2_BYTES), hipMemcpyDeviceToDevice, stream);
    }
    hipLaunchKernelGGL(dbg2_cmp, dim3(1024), dim3(256), 0, stream, (const unsigned*)((const char*)d_ws + (208u << 20)), (const unsigned*)(DBG2_SRC), (size_t)(DBG2_BYTES) / 4, (int)(DBG2_F32), (unsigned*)((char*)d_ws + (250u << 20)));
    hipLaunchKernelGGL(dbg2_fill, dim3(1024), dim3(256), 0, stream, (const unsigned*)((const char*)d_ws + (250u << 20)), (float*)d_out, (size_t)out_size);
#elif defined(DBG_STOP)
    for (int p = 0; p < DBG_STOP; ++p) { a.ph_lo = p; a.ph_hi = p + 1; hipLaunchKernelGGL(mk_fwd, dim3(grid), dim3(512), LDS_BYTES, stream, a); }
    hipLaunchKernelGGL(dbg_dump, dim3(1024), dim3(256), 0, stream, (const unsigned short*)((const char*)d_ws + (size_t)(DBG_OFF)), (size_t)(DBG_BYTES) / 2, (float*)d_out, (int)(DBG_KEEP));
#else
    for (int p = 0; p < N_PHASES; ++p) { a.ph_lo = p; a.ph_hi = p + 1; hipLaunchKernelGGL(mk_fwd, dim3(grid), dim3(512), LDS_BYTES, stream, a); }
#endif
#endif
}
```

```cpp
#include <hip/hip_runtime.h>
#include <hip/hip_cooperative_groups.h>
#include <cstdio>
#include <cstdint>
namespace cg = cooperative_groups;
namespace pg8 {
#define PG8_LAS __attribute__((address_space(3)))
typedef unsigned short bf16_t;
typedef short bf16x8 __attribute__((ext_vector_type(8)));
typedef float f32x4 __attribute__((ext_vector_type(4)));
typedef unsigned u32x4 __attribute__((ext_vector_type(4)));
constexpr int BM = 256, BK = 64, HALF = 128, HTB = HALF * BK * 2  , STAGE_BYTES = 8 * HTB, NXCD = 8, WGM = 8;

__host__ __device__ __forceinline__ int lds_byte(int r, int c) { const int st = (r >> 4) * 2 + (c >> 5), rr = r & 15, cc = c & 31, ob = rr * 64 + cc * 2; return st * 1024 + (ob ^ (((ob >> 9) & 1) << 5)); }
__host__ __device__ __forceinline__ void stage_rc(int b, int& R, int& C) { const int st = b / 1024, sb = b % 1024, swz = sb ^ (((sb >> 9) & 1) << 5); R = (st >> 1) * 16 + swz / 64; C = (st & 1) * 32 + (swz % 64) / 2; }
__host__ __device__ __forceinline__ int perm32(int rho) { const int n = rho >> 4, i = rho & 15; return 8 * (i >> 2) + 4 * n + (i & 3); }

struct Unit { int pm, pn; };
struct Gemm { const bf16_t* A; const bf16_t* Bt; int M, N, K; };

struct StaticOrder {
    int nM, nN, nwg, G, c;
    __host__ __device__ void init(int M, int N, int G_, int c_) { nM = M / BM; nN = N / BM; nwg = nM * nN; G = G_; c = c_; }
    __host__ __device__ bool next(int i, Unit& u) const {
        const long L = (long)i * G + c; if (L >= nwg) return false;
        int wgid = (int)L; { const int q = nwg / NXCD, r = nwg % NXCD, xcd = wgid % NXCD, off = wgid / NXCD; wgid = (xcd < r ? xcd * (q + 1) : r * (q + 1) + (xcd - r) * q) + off; }
        const int nig = WGM * nN, gid = wgid / nig, fm = gid * WGM, gsz = (nM - fm) < WGM ? (nM - fm) : WGM;
        u.pm = fm + ((wgid % nig) % gsz); u.pn = (wgid % nig) / gsz; return true;
    }
    __device__ __forceinline__ void a_ready(const Unit&) const {}
    __device__ __forceinline__ void done(const Unit&) const {}
};

__device__ __forceinline__ unsigned cvt_pk_bf16(float lo, float hi) { unsigned r; asm volatile("v_cvt_pk_bf16_f32 %0, %1, %2" : "=v"(r) : "v"(lo), "v"(hi)); return r; }
typedef float f32x2 __attribute__((ext_vector_type(2)));

template <class Epi, class Sched, bool ALIGN_EPI = false, bool SP2 = false>
__device__ __forceinline__ void gemm_phase(PG8_LAS unsigned char* lds, const Gemm g, const Sched& S, const Epi& E) {
    const int tid = threadIdx.x, wid = __builtin_amdgcn_readfirstlane(tid >> 6), lane = tid & 63, wr = wid >> 2, wc = wid & 3, fr = lane & 15, fq = lane >> 4;
    const int K = g.K, nt = K / BK;
    unsigned voffA[2], voffB[2];
#pragma unroll
    for (int i = 0; i < 2; ++i) { int R, C; stage_rc(tid * 16 + i * 8192, R, C); const int Rb = Epi::PERM ? ((R & ~31) + perm32(R & 31)) : R;
        voffA[i] = (unsigned)(R * K + C) * 2u; voffB[i] = (unsigned)(Rb * K + C) * 2u; }
    const size_t kstep = (size_t)(BK * 2);
    const size_t hstep = (size_t)HALF * K * 2;
    const size_t tstep = 2 * hstep;
    const unsigned ldsw = (unsigned)wid * 1024u;
    const int aoff = lds_byte(wr * 64 + fr, fq * 8), boff = lds_byte(wc * 32 + fr, fq * 8);
#define PG8_SA(b, h) (((b) * 2 + (h)) * HTB)
#define PG8_SB(b, h) ((4 + (b) * 2 + (h)) * HTB)
#define PG8_STAGE(bufoff, gbase, voff) do { _Pragma("unroll") for (int _i = 0; _i < 2; ++_i) \
        __builtin_amdgcn_global_load_lds((const unsigned*)((const char*)(gbase) + (voff)[_i]), (PG8_LAS unsigned*)(lds + (bufoff) + ldsw + _i * 8192), 16, 0, 0); } while (0)
#define PG8_LDA(dst, b, h) do { _Pragma("unroll") for (int m = 0; m < 4; ++m) _Pragma("unroll") for (int k = 0; k < 2; ++k) dst[m][k] = *(const PG8_LAS bf16x8*)(lds + PG8_SA(b, h) + aoff + m * 2048 + k * 1024); } while (0)
#define PG8_LDB(dst, b, h) do { _Pragma("unroll") for (int n = 0; n < 2; ++n) _Pragma("unroll") for (int k = 0; k < 2; ++k) dst[n][k] = *(const PG8_LAS bf16x8*)(lds + PG8_SB(b, h) + boff + n * 2048 + k * 1024); } while (0)
#define PG8_MMA(ai, bj, At, Bt) do { __builtin_amdgcn_s_setprio(1); _Pragma("unroll") for (int m = 0; m < 4; ++m) _Pragma("unroll") for (int n = 0; n < 2; ++n) _Pragma("unroll") for (int k = 0; k < 2; ++k) \
        acc[ai][bj][m][n] = __builtin_amdgcn_mfma_f32_16x16x32_bf16(Bt[n][k], At[m][k], acc[ai][bj][m][n], 0, 0, 0); __builtin_amdgcn_s_setprio(0); } while (0)
#define PG8_WAIT_V(n) asm volatile("s_waitcnt vmcnt(" #n ")" ::: "memory")
#define PG8_WAIT_L(n) asm volatile("s_waitcnt lgkmcnt(" #n ")" ::: "memory")
#define PG8_BAR __builtin_amdgcn_s_barrier()
#define PG8_SCHED __builtin_amdgcn_sched_barrier(0)
    Unit cur, nxt; int ui = 0;
    if (!S.next(0, cur)) return;
    f32x4 acc[2][2][4][2];
#pragma unroll
    for (int a = 0; a < 2; ++a)
#pragma unroll
        for (int b = 0; b < 2; ++b)
#pragma unroll
            for (int m = 0; m < 4; ++m)
#pragma unroll
                for (int n = 0; n < 2; ++n) acc[a][b][m][n] = (f32x4){0.f, 0.f, 0.f, 0.f};
    bf16x8 At[4][2], B0[2][2], B1[2][2];
    const char* cA = (const char*)g.A + (size_t)cur.pm * tstep; const char* cB = (const char*)g.Bt + (size_t)cur.pn * tstep;
    S.a_ready(cur);
    if constexpr (SP2) {
        PG8_STAGE(PG8_SB(0, 0), cB, voffB); PG8_STAGE(PG8_SB(0, 1), cB + hstep, voffB); PG8_STAGE(PG8_SA(0, 0), cA, voffA); PG8_STAGE(PG8_SA(0, 1), cA + hstep, voffA);
        if (wr == 1) PG8_BAR;
        PG8_WAIT_V(2); PG8_BAR;
        PG8_STAGE(PG8_SB(1, 0), cB + kstep, voffB); PG8_STAGE(PG8_SA(1, 0), cA + kstep, voffA); PG8_STAGE(PG8_SB(1, 1), cB + hstep + kstep, voffB);
        PG8_WAIT_V(6); PG8_BAR;
    } else {
        PG8_STAGE(PG8_SB(0, 0), cB, voffB); PG8_STAGE(PG8_SA(0, 0), cA, voffA); PG8_STAGE(PG8_SB(0, 1), cB + hstep, voffB); PG8_STAGE(PG8_SA(0, 1), cA + hstep, voffA);
        if (wr == 1) PG8_BAR;
        PG8_WAIT_V(4); PG8_BAR;
        PG8_STAGE(PG8_SB(1, 0), cB + kstep, voffB); PG8_STAGE(PG8_SA(1, 0), cA + kstep, voffA); PG8_STAGE(PG8_SB(1, 1), cB + hstep + kstep, voffB);
        PG8_WAIT_V(6); PG8_BAR;
    }
    for (;;) {
        const bool has_next = S.next(ui + 1, nxt);
        const char* nA = has_next ? (const char*)g.A + (size_t)nxt.pm * tstep : cA; const char* nB = has_next ? (const char*)g.Bt + (size_t)nxt.pn * tstep : cB;
        for (int t = 0; t < nt; t += 2) {
            const bool last = (t == nt - 2);
            const char* a1 = cA + (size_t)(t + 1) * kstep;
            const char* a2 = last ? nA : cA + (size_t)(t + 2) * kstep; const char* b2 = last ? nB : cB + (size_t)(t + 2) * kstep;
            const char* a3 = a2 + kstep; const char* b3 = b2 + kstep;
            if (last && has_next) S.a_ready(nxt);
            if constexpr (SP2) {
            PG8_LDB(B0, 0, 0); PG8_LDB(B1, 0, 1); PG8_SCHED; PG8_LDA(At, 0, 0); PG8_STAGE(PG8_SA(1, 1), a1 + hstep, voffA);
            PG8_WAIT_V(8); PG8_WAIT_L(0); PG8_BAR; PG8_MMA(0, 0, At, B0); PG8_MMA(0, 1, At, B1); PG8_BAR; PG8_SCHED;
            PG8_LDA(At, 0, 1); PG8_STAGE(PG8_SB(0, 0), b2, voffB); PG8_STAGE(PG8_SB(0, 1), b2 + hstep, voffB); PG8_STAGE(PG8_SA(0, 0), a2, voffA);
            PG8_WAIT_V(8); PG8_WAIT_L(0); PG8_BAR; PG8_MMA(1, 0, At, B0); PG8_MMA(1, 1, At, B1); PG8_BAR; PG8_SCHED;
            PG8_LDB(B0, 1, 0); PG8_LDB(B1, 1, 1); PG8_SCHED; PG8_LDA(At, 1, 0); PG8_STAGE(PG8_SA(0, 1), a2 + hstep, voffA);
            PG8_WAIT_V(8); PG8_WAIT_L(0); PG8_BAR; PG8_MMA(0, 0, At, B0); PG8_MMA(0, 1, At, B1); PG8_BAR; PG8_SCHED;
            PG8_LDA(At, 1, 1); PG8_STAGE(PG8_SB(1, 0), b3, voffB); PG8_STAGE(PG8_SB(1, 1), b3 + hstep, voffB); PG8_STAGE(PG8_SA(1, 0), a3, voffA);
            PG8_WAIT_V(8); PG8_WAIT_L(0); PG8_BAR; PG8_MMA(1, 0, At, B0); PG8_MMA(1, 1, At, B1); PG8_BAR; PG8_SCHED;
            } else {
            PG8_LDB(B0, 0, 0); PG8_SCHED; PG8_LDA(At, 0, 0); PG8_STAGE(PG8_SA(1, 1), a1 + hstep, voffA);
            PG8_WAIT_L(8); PG8_BAR; PG8_WAIT_L(0); PG8_MMA(0, 0, At, B0); PG8_BAR; PG8_SCHED;
            PG8_LDB(B1, 0, 1); PG8_STAGE(PG8_SB(0, 0), b2, voffB);
            PG8_BAR; PG8_WAIT_L(0); PG8_MMA(0, 1, At, B1); PG8_BAR;
            PG8_LDA(At, 0, 1); PG8_STAGE(PG8_SA(0, 0), a2, voffA);
            PG8_BAR; PG8_WAIT_L(0); PG8_MMA(1, 0, At, B0); PG8_BAR; PG8_SCHED;
            PG8_STAGE(PG8_SB(0, 1), b2 + hstep, voffB);
            PG8_WAIT_V(6); PG8_BAR; PG8_MMA(1, 1, At, B1); PG8_BAR;
            PG8_LDB(B0, 1, 0); PG8_SCHED; PG8_LDA(At, 1, 0); PG8_STAGE(PG8_SA(0, 1), a2 + hstep, voffA);
            PG8_WAIT_L(8); PG8_BAR; PG8_WAIT_L(0); PG8_MMA(0, 0, At, B0); PG8_BAR; PG8_SCHED;
            PG8_LDB(B1, 1, 1); PG8_STAGE(PG8_SB(1, 0), b3, voffB);
            PG8_BAR; PG8_WAIT_L(0); PG8_MMA(0, 1, At, B1); PG8_BAR;
            PG8_LDA(At, 1, 1); PG8_STAGE(PG8_SA(1, 0), a3, voffA);
            PG8_BAR; PG8_WAIT_L(0); PG8_MMA(1, 0, At, B0); PG8_BAR; PG8_SCHED;
            PG8_STAGE(PG8_SB(1, 1), b3 + hstep, voffB);
            PG8_WAIT_V(6); PG8_BAR; PG8_MMA(1, 1, At, B1); PG8_BAR;
            }
        }
        if constexpr (ALIGN_EPI) { if (wr == 0) PG8_BAR; }
        if constexpr (!Epi::AFTER_DRAIN) { E(acc, cur, wr, wc, fr, fq); S.done(cur); }
        if (!has_next) break;
#pragma unroll
        for (int a = 0; a < 2; ++a)
#pragma unroll
            for (int b = 0; b < 2; ++b)
#pragma unroll
                for (int m = 0; m < 4; ++m)
#pragma unroll
                    for (int n = 0; n < 2; ++n) acc[a][b][m][n] = (f32x4){0.f, 0.f, 0.f, 0.f};
        cur = nxt; cA = nA; cB = nB; ++ui;
        if constexpr (ALIGN_EPI) { if (wr == 1) PG8_BAR; }
    }
    PG8_WAIT_V(0);
    if constexpr (!ALIGN_EPI) { if (wr == 0) PG8_BAR; }
    PG8_BAR;
    if constexpr (Epi::AFTER_DRAIN) { E.fused(acc, cur, wr, wc, fr, fq, lds, wid, lane); S.done(cur); }
#undef PG8_SA
#undef PG8_SB
#undef PG8_STAGE
#undef PG8_LDA
#undef PG8_LDB
#undef PG8_MMA
#undef PG8_WAIT_V
#undef PG8_WAIT_L
#undef PG8_BAR
#undef PG8_SCHED
}
}

#ifndef MK_ONE_LAUNCH
#define MK_ONE_LAUNCH 1
#endif
#define LAS __attribute__((address_space(3)))
typedef unsigned short bf16;
typedef float f32x4 __attribute__((ext_vector_type(4)));
typedef unsigned u32x4 __attribute__((ext_vector_type(4)));
typedef unsigned u32x2 __attribute__((ext_vector_type(2)));

constexpr int D = 1024, NTOK = 10240, NPT = 8192, LP = 256, LS = 1024, NSEQ = 34;
constexpr int NPROJ = 3584, NIN = 3600, DFF = 4096, PLD = 2816;
constexpr int SC_OFF = 0, ML_OFF = 768;
constexpr float EPS = 1e-6f;
constexpr size_t MiB = 1u << 20;
constexpr size_t WS_CTL = 0, CTL_BYTES = 262144;
constexpr size_t WS_WIN = 1 * MiB, WS_WOUT = 15 * MiB, WS_W1 = 19 * MiB, WS_W2 = 35 * MiB, WS_MOD = 51 * MiB, WS_FILT = 52 * MiB, WS_GATES = 62 * MiB;
constexpr size_t WS_U = 63 * MiB, WS_Y = 83 * MiB, WS_HF = 103 * MiB, WS_HB = 113 * MiB, WS_PROJ = 123 * MiB, WS_HYT = 203 * MiB, WS_YHT = 218 * MiB, WS_END = 223 * MiB;
constexpr int LDS_BYTES = 155648;
constexpr size_t OUT_YS = 8388608, OUT_C = 10485760, OUT_N = 18874368, OUT_M = 18939904;
constexpr size_t FILT_L = 5 * MiB / 4;

struct Args { const float* in[28]; float* out; unsigned char* ws; int ph_lo, ph_hi; };
typedef const __attribute__((address_space(4))) Args CArgs;
#define PHASE_ARGS() const __attribute__((address_space(4))) Args* ap_ = (const __attribute__((address_space(4))) Args*)__builtin_amdgcn_kernarg_segment_ptr(); asm volatile("" : "+s"(ap_)); CArgs& a = *ap_
enum { I_XP = 0, I_XS, I_SC, I_SN, I_SM, I_C, I_CCTX, I_N1G, I_ADAW, I_ADAB, I_WIN, I_SCW, I_HYCW, I_HW1, I_HB1, I_HW2, I_HB2, I_HW3, I_HFREQ, I_HSKIP, I_MLCW, I_MLGB, I_MLNG, I_WOUT, I_N2G, I_W1, I_W2, I_NFG };

typedef float f32x2_t __attribute__((ext_vector_type(2))); typedef __bf16 bf16x2_t __attribute__((ext_vector_type(2)));
__device__ __forceinline__ unsigned cvtpk(float lo, float hi) { f32x2_t v = {lo, hi}; bf16x2_t b = __builtin_convertvector(v, bf16x2_t); return __builtin_bit_cast(unsigned, b); }
__device__ __forceinline__ unsigned f2bf(float f) { unsigned u = __builtin_bit_cast(unsigned, f); return (u + 0x7fffu + ((u >> 16) & 1u)) >> 16; }
__device__ __forceinline__ unsigned pk2(float lo, float hi) { return f2bf(lo) | (f2bf(hi) << 16); }
__device__ __forceinline__ float bflo(unsigned u) { return __builtin_bit_cast(float, u << 16); }
__device__ __forceinline__ float bfhi(unsigned u) { return __builtin_bit_cast(float, u & 0xffff0000u); }
__device__ __forceinline__ void unpack8(const u32x4 v, float* f) { f[0] = bflo(v.x); f[1] = bfhi(v.x); f[2] = bflo(v.y); f[3] = bfhi(v.y); f[4] = bflo(v.z); f[5] = bfhi(v.z); f[6] = bflo(v.w); f[7] = bfhi(v.w); }
__device__ __forceinline__ u32x4 ld8(const bf16* p) { return *(const u32x4*)p; }
#define DPP_ADD(v, CTRL) ((v) + __builtin_bit_cast(float, __builtin_amdgcn_update_dpp(0, __builtin_bit_cast(int, (v)), (CTRL), 0xf, 0xf, true)))
__device__ __forceinline__ float wave_sum(float v) {
    v = DPP_ADD(v, 0xB1);
    v = DPP_ADD(v, 0x4E);
    v = DPP_ADD(v, 0x141);
    v = DPP_ADD(v, 0x140);
    const float r0 = __builtin_bit_cast(float, __builtin_amdgcn_readlane(__builtin_bit_cast(int, v), 0)), r1 = __builtin_bit_cast(float, __builtin_amdgcn_readlane(__builtin_bit_cast(int, v), 16));
    const float r2 = __builtin_bit_cast(float, __builtin_amdgcn_readlane(__builtin_bit_cast(int, v), 32)), r3 = __builtin_bit_cast(float, __builtin_amdgcn_readlane(__builtin_bit_cast(int, v), 48));
    return (r0 + r1) + (r2 + r3);
}
__device__ __forceinline__ float silu_f(float x) { return x / (1.f + __expf(-x)); }
__device__ __forceinline__ float sigmoid_f(float x) { return 1.f / (1.f + __expf(-x)); }
__device__ __forceinline__ int opaque_tid() { int t = threadIdx.x; asm volatile("" : "+v"(t)); return t; }
__device__ __forceinline__ int tok_kind(int r) { return r < NPT ? 0 : 1 + ((r - NPT) >> 10); }

template <bool WIN> __device__ __forceinline__ void p0_transpose_item(const float* W, int ldw, int K, int N, bf16* WT, float* scr, int item, int lane) {
    const int nblk = N / 32, kb = item / nblk, nb = item % nblk, k0 = 64 * kb, n0 = 32 * nb;
    const int ns = !WIN ? n0 : (n0 < 768 ? n0 : (n0 < 2816 ? n0 + 768 : n0 - 2048));
    float wv[32];
#pragma unroll
    for (int i = 0; i < 32; ++i) { const int kk = 2 * i + (lane >> 5); wv[i] = W[(size_t)(k0 + kk) * ldw + ns + (lane & 31)]; }
#pragma unroll
    for (int i = 0; i < 32; ++i) { const int kk = 2 * i + (lane >> 5); scr[kk * 33 + (lane & 31)] = wv[i]; }
    asm volatile("s_waitcnt lgkmcnt(0)" ::: "memory");
    const int c = lane & 7;
#pragma unroll
    for (int j = 0; j < 4; ++j) { const int n = (lane >> 3) + 8 * j; const float* s = scr + (8 * c) * 33 + n;
        u32x4 o; o.x = pk2(s[0 * 33], s[1 * 33]); o.y = pk2(s[2 * 33], s[3 * 33]); o.z = pk2(s[4 * 33], s[5 * 33]); o.w = pk2(s[6 * 33], s[7 * 33]);
        *(u32x4*)(WT + (size_t)(n0 + n) * K + k0 + 8 * c) = o; }
    asm volatile("s_waitcnt lgkmcnt(0)" ::: "memory");
}

constexpr int TR_IN = 16 * 112, TR_O = 16 * 32, TR_1 = 16 * 128, TR_2 = 64 * 32, TR_PER = TR_IN + TR_O + TR_1 + TR_2;
constexpr int TR_DEFER_ITEMS = (TR_PER - TR_IN + 63) / 64;
constexpr int TR_L1_ITEMS = TR_PER / 64;
#ifndef TR_QUOTA
#define TR_QUOTA 5
#endif
__device__ __forceinline__ void p0_transpose_any(CArgs& a, float* scr, int it, int lane) {
    unsigned char* ws = a.ws;
    const int l = it / TR_PER; int r = it % TR_PER;
    if (r < TR_IN) { p0_transpose_item<true>(a.in[I_WIN] + (size_t)l * 1024 * NIN, NIN, 1024, NPROJ, (bf16*)(ws + WS_WIN) + (size_t)l * NPROJ * 1024, scr, r, lane); return; } r -= TR_IN;
    if (r < TR_O) { p0_transpose_item<false>(a.in[I_WOUT] + (size_t)l * 1024 * 1024, 1024, 1024, 1024, (bf16*)(ws + WS_WOUT) + (size_t)l * 1024 * 1024, scr, r, lane); return; } r -= TR_O;
    if (r < TR_1) { p0_transpose_item<false>(a.in[I_W1] + (size_t)l * 1024 * DFF, DFF, 1024, DFF, (bf16*)(ws + WS_W1) + (size_t)l * DFF * 1024, scr, r, lane); return; } r -= TR_1;
    p0_transpose_item<false>(a.in[I_W2] + (size_t)l * DFF * 1024, 1024, DFF, 1024, (bf16*)(ws + WS_W2) + (size_t)l * 1024 * DFF, scr, r, lane);
}
__device__ __forceinline__ void filter_block_item(CArgs& a, unsigned char* lds, int it) {
    const int tid = opaque_tid(), lane = tid & 63, wave = __builtin_amdgcn_readfirstlane(tid >> 6);
    unsigned char* ws = a.ws; float* fl = (float*)lds;
    __syncthreads();
        const int l = it / 80, r = it % 80, Lsel = r >= 16, mb = Lsel ? r - 16 : r, L = Lsel ? 1024 : 256, m0 = mb * 16;
        float* z = fl;
        float* h1 = fl + 16 * 33;
        float* h2 = h1 + 16 * 64;
        if (tid < 256) { const int mi = tid >> 4, band = (tid & 15) + 1, m = m0 + mi; const int ph = (m * band) % L;
            float sn, cs; sincospif(2.0f * (float)ph / (float)L, &sn, &cs);
            z[mi * 33 + band] = cs; z[mi * 33 + 16 + band] = -sn; if (band == 1) z[mi * 33] = (float)m / (float)(L - 1); }
        __syncthreads();
        const float* w1 = a.in[I_HW1] + l * 33 * 64; const float* w2 = a.in[I_HW2] + l * 64 * 64; const float* w3 = a.in[I_HW3] + (size_t)l * 64 * 1024;
        { const int j = tid & 63; const float fj = a.in[I_HFREQ][l * 64 + j], bj = a.in[I_HB1][l * 64 + j];
          float wc[33];
#pragma unroll
          for (int k = 0; k < 33; ++k) wc[k] = w1[k * 64 + j];
#pragma unroll
          for (int h = 0; h < 2; ++h) { const int mi = (tid >> 6) + 8 * h; float d = bj;
#pragma unroll
              for (int k = 0; k < 33; ++k) d += z[mi * 33 + k] * wc[k];
              h1[mi * 64 + j] = sinf(fj * d); } }
        __syncthreads();
        { const int j = tid & 63; const float fj = a.in[I_HFREQ][l * 64 + j], bj = a.in[I_HB2][l * 64 + j];
          float wc[64];
#pragma unroll
          for (int k = 0; k < 64; ++k) wc[k] = w2[k * 64 + j];
#pragma unroll
          for (int h = 0; h < 2; ++h) { const int mi = (tid >> 6) + 8 * h; float d = bj;
#pragma unroll
              for (int k = 0; k < 64; ++k) d += h1[mi * 64 + k] * wc[k];
              h2[mi * 64 + j] = sinf(fj * d); } }
        __syncthreads();
        float* Gf = (float*)(ws + WS_FILT) + (size_t)l * FILT_L + (Lsel ? 262144 : 0);
#pragma unroll 1
        for (int h = 0; h < 2; ++h) { const int col = 64 * (wave + 8 * h) + lane, o = col >> 9, dd = (col >> 8) & 1, c = col & 255;
            float acc[16];
#pragma unroll
            for (int mi = 0; mi < 16; ++mi) acc[mi] = 0.f;
#pragma unroll 1
            for (int k0 = 0; k0 < 64; k0 += 32) { float wv[32];
#pragma unroll
                for (int kk = 0; kk < 32; ++kk) wv[kk] = w3[(k0 + kk) * 1024 + col];
#pragma unroll
                for (int kk = 0; kk < 32; ++kk)
#pragma unroll
                    for (int mi = 0; mi < 16; ++mi) acc[mi] += h2[mi * 64 + k0 + kk] * wv[kk]; }
            const float la = logf(1e-2f) / 1.5f, lb = logf(1e-2f) / 0.3f; const float delta = fabsf(la + (float)c * ((lb - la) / 255.0f));
            float* gp = Gf + (size_t)(o * 256 + c) * (2 * L) + L;
#pragma unroll
            for (int mi = 0; mi < 16; ++mi) { const int m = m0 + mi; const float t = (float)m / (float)(L - 1); const float v = acc[mi] * expf(-t * delta);
                if (dd == 0) gp[m] = v; else if (m > 0) gp[-m] = v; } }
        __syncthreads();
}
__device__ __forceinline__ void p0_prologue(CArgs& a, unsigned char* lds) {
    const int tid = threadIdx.x, lane = tid & 63, wave = tid >> 6, G = gridDim.x, bid = blockIdx.x;
    unsigned char* ws = a.ws;
    float* fl = (float*)lds;
    bool have_svec = false;
    const bool pv = a.ph_hi >= 1000;
#ifndef PV
#define PV 0
#endif
    for (int it = bid; it < 192; it += G) {
        if (!have_svec) {
            for (int i = tid; i < 3 * 1024; i += 512) { const int kind = i >> 10, k = i & 1023; const float v = kind == 0 ? a.in[I_CCTX][k] : a.in[I_C][(kind - 1) * 1024 + k]; fl[i] = silu_f(v); }
            have_svec = true;
        }
        __syncthreads();
        const int l = it / 96, cgp = it % 96;
        const float* W = a.in[I_ADAW] + (size_t)l * 1024 * 6144 + cgp * 64;
        const int c4 = lane & 15, kr = lane >> 4;
        f32x4 acc[3]; acc[0] = acc[1] = acc[2] = (f32x4){0.f, 0.f, 0.f, 0.f};
#pragma unroll 8
        for (int i = 0; i < 32; ++i) { const int k = wave * 128 + 4 * i + kr; const f32x4 w = *(const f32x4*)(W + (size_t)k * 6144 + 4 * c4);
            acc[0] += w * fl[k]; acc[1] += w * fl[1024 + k]; acc[2] += w * fl[2048 + k]; }
#pragma unroll
        for (int kd = 0; kd < 3; ++kd)
#pragma unroll
            for (int e = 0; e < 4; ++e) { float v = acc[kd][e]; v += __shfl_xor(v, 16); v += __shfl_xor(v, 32); acc[kd][e] = v; }
        float* red = fl + 3072;
        if (kr == 0) {
#pragma unroll
            for (int kd = 0; kd < 3; ++kd)
#pragma unroll
                for (int e = 0; e < 4; ++e) red[(wave * 3 + kd) * 64 + 4 * c4 + e] = acc[kd][e];
        }
        __syncthreads();
        if (tid < 192) { const int kd = tid >> 6, c = tid & 63; float s = a.in[I_ADAB][l * 6144 + cgp * 64 + c];
#pragma unroll
            for (int w = 0; w < 8; ++w) s += red[(w * 3 + kd) * 64 + c];
            ((float*)(ws + WS_MOD))[(l * 3 + kd) * 6144 + cgp * 64 + c] = s; }
        asm volatile("s_waitcnt vmcnt(0)" ::: "memory");
        __syncthreads();
        if (tid == 0) { __builtin_amdgcn_fence(__ATOMIC_RELEASE, "agent"); asm volatile("s_waitcnt vmcnt(0)" ::: "memory"); (void)__hip_atomic_fetch_add((unsigned*)(ws + WS_CTL) + 64 * 11, 1u, __ATOMIC_RELAXED, __HIP_MEMORY_SCOPE_AGENT); }
    }
    __syncthreads();
    {
        float* scr = fl + wave * 4096;
        if (!(pv && PV == 4)) for (int it = bid * 8 + wave; it < TR_IN; it += G * 8) p0_transpose_any(a, scr, it, lane);
    }
    __syncthreads();
    if (!(pv && PV == 1)) for (int it = (G - 1 - bid); it < 80; it += G) filter_block_item(a, lds, it);
    __syncthreads();
}
__device__ __forceinline__ int trq_fetch(CArgs& a, unsigned char* lds) {
    volatile unsigned* slot = (volatile unsigned*)(lds + LDS_BYTES - 192);
    __syncthreads();
    if (threadIdx.x == 0) *slot = atomicAdd((unsigned*)(a.ws + WS_CTL) + 64 * 9, 1u);
    __syncthreads();
    return __builtin_amdgcn_readfirstlane((int)*slot);
}
__device__ __forceinline__ void transpose_block_item(CArgs& a, unsigned char* lds, int item, int base = TR_IN, int lim = TR_PER) {
    const int tid = opaque_tid(), lane = tid & 63, wave = __builtin_amdgcn_readfirstlane(tid >> 6);
    float* scr = (float*)lds + wave * 4096;
    __syncthreads();
#pragma unroll 1
    for (int k = 0; k < 8; ++k) { const int it = base + 64 * item + wave * 8 + k; if (it < lim) p0_transpose_any(a, scr, it, lane); }
}

__device__ __forceinline__ float bperm_xor(float v, int lane, int k) { return __builtin_bit_cast(float, __builtin_amdgcn_ds_bpermute((lane ^ k) << 2, __builtin_bit_cast(int, v))); }
__device__ __forceinline__ float fold16(const float (&p)[16], int lane) {
    float q8[8], q4[4], q2[2];
    const bool b5 = lane & 32, b4 = lane & 16, b3 = lane & 8, b2 = lane & 4;
#pragma unroll
    for (int i = 0; i < 8; ++i) { const float send = b5 ? p[i] : p[8 + i], keep = b5 ? p[8 + i] : p[i]; q8[i] = keep + bperm_xor(send, lane, 32); }
#pragma unroll
    for (int i = 0; i < 4; ++i) { const float send = b4 ? q8[i] : q8[4 + i], keep = b4 ? q8[4 + i] : q8[i]; q4[i] = keep + bperm_xor(send, lane, 16); }
#pragma unroll
    for (int i = 0; i < 2; ++i) { const float send = b3 ? q4[i] : q4[2 + i], keep = b3 ? q4[2 + i] : q4[i]; q2[i] = keep + bperm_xor(send, lane, 8); }
    float v = (b2 ? q2[1] : q2[0]) + bperm_xor(b2 ? q2[0] : q2[1], lane, 4);
    v = DPP_ADD(v, 0x4E); v = DPP_ADD(v, 0xB1);
    return v;
}
__device__ __forceinline__ void norm_wg_load(CArgs& a, unsigned char* lds, int l) {
    float* wg = (float*)lds; const int tid = threadIdx.x;
    const float* W = a.in[I_WIN] + (size_t)l * 1024 * NIN + NPROJ;
    for (int i = tid; i < 4096; i += 512) { const int k = i >> 2, j4 = i & 3; const f32x4 v = *(const f32x4*)(W + (size_t)k * NIN + 4 * j4);
        wg[(4 * j4 + 0) * 1024 + k] = v.x; wg[(4 * j4 + 1) * 1024 + k] = v.y; wg[(4 * j4 + 2) * 1024 + k] = v.z; wg[(4 * j4 + 3) * 1024 + k] = v.w; }
    __syncthreads();
}
template <int MODE, bool GATES, bool FINAL>
__device__ __forceinline__ void norm_rows(CArgs& a, unsigned char* lds, int l, int which, int first, int stride, int rend, bool load_wg = true) {
    const int tid = opaque_tid(), lane = tid & 63;
    float* X = a.ph_hi >= 1000 ? (float*)(a.ws + WS_PROJ) : a.out; bf16* U = (bf16*)(a.ws + WS_U); float* GT = (float*)(a.ws + WS_GATES);
    const float* mod = (const float*)(a.ws + WS_MOD) + (size_t)l * 3 * 6144;
    float* wg = (float*)lds;
    if (GATES && load_wg) norm_wg_load(a, lds, l);
    const float* gvec = FINAL ? a.in[I_NFG] : (which == 1 ? a.in[I_N1G] + l * 1024 : a.in[I_N2G] + l * 1024);
    constexpr int RB = GATES ? 1 : 5;
    for (int r0 = first; r0 < rend; r0 += stride * RB) {
        f32x4 vv[5][4];
#pragma unroll
        for (int k = 0; k < RB; ++k) { int r = r0 + k * stride; r = r < rend ? r : rend - 1;
            const float* src = (MODE == 0) ? (r < NPT ? a.in[I_XP] + (size_t)r * D : a.in[I_XS] + (size_t)(r - NPT) * D) : X + (size_t)r * D;
#pragma unroll
            for (int j = 0; j < 4; ++j) vv[k][j] = *(const f32x4*)(src + 4 * lane + 256 * j); }
#define NORM_ROW(KK) if (KK < RB) { const int r = r0 + KK * stride; if (r < rend) {\
            f32x4 v[4]; v[0] = vv[KK][0]; v[1] = vv[KK][1]; v[2] = vv[KK][2]; v[3] = vv[KK][3];\
            if (MODE == 0) {\
                if (r >= NPT) { const int t = (r - NPT) & 1023; const float pr = (float)(t >> 6), pc = (float)(t & 63);\
            _Pragma("unroll")\
                    for (int j = 0; j < 4; ++j) { const float p = (j < 2) ? pr : pc;\
            _Pragma("unroll")\
                        for (int e = 0; e < 4; ++e) { const int i = 4 * lane + e; const float om = __builtin_amdgcn_exp2f((float)i * (-13.287712379549449f / 256.0f)); const float ang = p * om; v[j][e] += (j & 1) ? __cosf(ang) : __sinf(ang); } } }\
            _Pragma("unroll")\
                for (int j = 0; j < 4; ++j) *(f32x4*)(X + (size_t)r * D + 4 * lane + 256 * j) = v[j];\
            }\
            float ss = 0.f;\
            _Pragma("unroll")\
            for (int j = 0; j < 4; ++j) ss += (v[j].x * v[j].x + v[j].y * v[j].y) + (v[j].z * v[j].z + v[j].w * v[j].w);\
            const float rstd = 1.0f / sqrtf(wave_sum(ss) * (1.0f / D) + EPS);\
            if (FINAL) {\
            _Pragma("unroll")\
                for (int j = 0; j < 4; ++j) { const f32x4 g = *(const f32x4*)(gvec + 4 * lane + 256 * j); *(f32x4*)(X + (size_t)r * D + 4 * lane + 256 * j) = v[j] * rstd * g; }\
            } else {\
            const int kind = tok_kind(r);\
            const float* sh = mod + kind * 6144 + (which == 1 ? 0 : 3072); const float* sc = sh + 1024;\
            _Pragma("unroll")\
            for (int j = 0; j < 4; ++j) { const int c = 4 * lane + 256 * j; const f32x4 g = *(const f32x4*)(gvec + c), s1 = *(const f32x4*)(sc + c), s0 = *(const f32x4*)(sh + c);\
                v[j] = v[j] * rstd * g * (s1 + 1.0f) + s0;\
                u32x2 o; o.x = cvtpk(v[j].x, v[j].y); o.y = cvtpk(v[j].z, v[j].w); *(u32x2*)(U + (size_t)r * D + c) = o; }\
            if (GATES) {\
                float p16[16];\
            _Pragma("unroll")\
                for (int g = 0; g < 16; ++g) p16[g] = 0.f;\
            _Pragma("unroll")\
                for (int j = 0; j < 4; ++j) {\
            _Pragma("unroll")\
                    for (int g = 0; g < 8; ++g) { const f32x4 w = *(const f32x4*)(wg + g * 1024 + 4 * lane + 256 * j); p16[g] += (v[j].x * w.x + v[j].y * w.y) + (v[j].z * w.z + v[j].w * w.w); }\
                    __builtin_amdgcn_sched_barrier(0);\
            _Pragma("unroll")\
                    for (int g = 8; g < 16; ++g) { const f32x4 w = *(const f32x4*)(wg + g * 1024 + 4 * lane + 256 * j); p16[g] += (v[j].x * w.x + v[j].y * w.y) + (v[j].z * w.z + v[j].w * w.w); }\
                    __builtin_amdgcn_sched_barrier(0); }\
                { const float tot = fold16(p16, lane); const int gi = ((lane >> 5) & 1) * 8 + ((lane >> 4) & 1) * 4 + ((lane >> 3) & 1) * 2 + ((lane >> 2) & 1);\
                  if ((lane & 3) == 0) GT[(size_t)r * 16 + gi] = tot + a.in[I_MLGB][l * 16 + gi]; }\
            }\
            } } }
        NORM_ROW(0) NORM_ROW(1) NORM_ROW(2) NORM_ROW(3) NORM_ROW(4)
#undef NORM_ROW
    }
}

template <int MODE, bool GATES, bool FINAL>
__device__ __forceinline__ void norm_phase(CArgs& a, unsigned char* lds, int l, int which) {
    norm_rows<MODE, GATES, FINAL>(a, lds, l, which, blockIdx.x * 8 + (threadIdx.x >> 6), gridDim.x * 8, NTOK);
}

template <int ACT> struct EpiBf16 {
    static constexpr bool PERM = true, AFTER_DRAIN = false;
    bf16* O; int ldc;
    __device__ __forceinline__ void operator()(const pg8::f32x4 (&acc)[2][2][4][2], const pg8::Unit& u, int wr, int wc, int fr, int fq) const {
        const int row0 = u.pm * 256 + wr * 64 + fr, col0 = u.pn * 256 + wc * 32 + 8 * fq;
#pragma unroll
        for (int ai = 0; ai < 2; ++ai)
#pragma unroll
            for (int m = 0; m < 4; ++m) { bf16* rowp = O + (size_t)(row0 + ai * 128 + m * 16) * ldc + col0;
#pragma unroll
                for (int bj = 0; bj < 2; ++bj) { pg8::f32x4 v0 = acc[ai][bj][m][0], v1 = acc[ai][bj][m][1];
                    if (ACT == 1) {
#pragma unroll
                        for (int e = 0; e < 4; ++e) { const float p = fmaxf(v0[e], 0.f), q = fmaxf(v1[e], 0.f); v0[e] = p * p; v1[e] = q * q; } }
                    u32x4 w; w.x = pg8::cvt_pk_bf16(v0[0], v0[1]); w.y = pg8::cvt_pk_bf16(v0[2], v0[3]); w.z = pg8::cvt_pk_bf16(v1[0], v1[1]); w.w = pg8::cvt_pk_bf16(v1[2], v1[3]);
                    *(u32x4*)(rowp + bj * 128) = w; } }
    }
};
struct EpiResid {
    static constexpr bool PERM = false, AFTER_DRAIN = false;
    float* X; const float* gate;
    __device__ __forceinline__ void operator()(const pg8::f32x4 (&acc)[2][2][4][2], const pg8::Unit& u, int wr, int wc, int fr, int fq) const {
        const int row0 = u.pm * 256 + wr * 64 + fr, col0 = u.pn * 256 + wc * 32 + 4 * fq;
        const int kind = u.pm < 32 ? 0 : 1 + ((u.pm - 32) >> 2);
        pg8::f32x4 gv[2][2];
#pragma unroll
        for (int bj = 0; bj < 2; ++bj)
#pragma unroll
            for (int n = 0; n < 2; ++n) gv[bj][n] = *(const pg8::f32x4*)(gate + kind * 6144 + col0 + bj * 128 + n * 16);
#pragma unroll
        for (int ai = 0; ai < 2; ++ai) {
            pg8::f32x4 xv[4][2][2];
#pragma unroll
            for (int m = 0; m < 4; ++m) { const float* rowp = X + (size_t)(row0 + ai * 128 + m * 16) * D + col0;
#pragma unroll
                for (int bj = 0; bj < 2; ++bj)
#pragma unroll
                    for (int n = 0; n < 2; ++n) xv[m][bj][n] = *(const pg8::f32x4*)(rowp + bj * 128 + n * 16); }
#pragma unroll
            for (int m = 0; m < 4; ++m) { float* rowp = X + (size_t)(row0 + ai * 128 + m * 16) * D + col0;
#pragma unroll
                for (int bj = 0; bj < 2; ++bj)
#pragma unroll
                    for (int n = 0; n < 2; ++n) *(pg8::f32x4*)(rowp + bj * 128 + n * 16) = xv[m][bj][n] + gv[bj][n] * acc[ai][bj][m][n]; } }
    }
};

__device__ __forceinline__ void gates_block_item(CArgs& a, unsigned char* lds, int l, int item) {
    const int tid = opaque_tid(), lane = tid & 63, wave = __builtin_amdgcn_readfirstlane(tid >> 6);
    const bf16* U = (const bf16*)(a.ws + WS_U); float* GT = (float*)(a.ws + WS_GATES); const float* wg = (const float*)lds;
    const int gi = ((lane >> 5) & 1) * 8 + ((lane >> 4) & 1) * 4 + ((lane >> 3) & 1) * 2 + ((lane >> 2) & 1);
    const float gb = a.in[I_MLGB][l * 16 + gi];
    u32x2 raw[5][4];
#pragma unroll
    for (int k = 0; k < 5; ++k) { const int r = 40 * item + wave + 8 * k;
#pragma unroll
        for (int j = 0; j < 4; ++j) raw[k][j] = *(const u32x2*)(U + (size_t)r * D + 4 * lane + 256 * j); }
#pragma unroll
    for (int k = 0; k < 5; ++k) { const int r = 40 * item + wave + 8 * k;
        float p16[16];
#pragma unroll
        for (int g = 0; g < 16; ++g) p16[g] = 0.f;
#pragma unroll
        for (int j = 0; j < 4; ++j) { const float v0 = bflo(raw[k][j].x), v1 = bfhi(raw[k][j].x), v2 = bflo(raw[k][j].y), v3 = bfhi(raw[k][j].y);
#pragma unroll
            for (int g = 0; g < 8; ++g) { const f32x4 w = *(const f32x4*)(wg + g * 1024 + 4 * lane + 256 * j); p16[g] += (v0 * w.x + v1 * w.y) + (v2 * w.z + v3 * w.w); }
            __builtin_amdgcn_sched_barrier(0);
#pragma unroll
            for (int g = 8; g < 16; ++g) { const f32x4 w = *(const f32x4*)(wg + g * 1024 + 4 * lane + 256 * j); p16[g] += (v0 * w.x + v1 * w.y) + (v2 * w.z + v3 * w.w); }
            __builtin_amdgcn_sched_barrier(0); }
        const float tot = fold16(p16, lane);
        if ((lane & 3) == 0) GT[(size_t)r * 16 + gi] = tot + gb; }
}
__device__ __forceinline__ bool first_unit(int nM, int nN, int c, pg8::Unit& u) {
    const int nwg = nM * nN; if (c >= nwg) return false;
    int wgid = c; { const int q = nwg / pg8::NXCD, r = nwg % pg8::NXCD, xcd = wgid % pg8::NXCD, off = wgid / pg8::NXCD; wgid = (xcd < r ? xcd * (q + 1) : r * (q + 1) + (xcd - r) * q) + off; }
    const int nig = pg8::WGM * nN, gid = wgid / nig, fm = gid * pg8::WGM, gsz = (nM - fm) < pg8::WGM ? (nM - fm) : pg8::WGM;
    u.pm = fm + ((wgid % nig) % gsz); u.pn = (wgid % nig) / gsz; return true;
}
template <bool GATES, bool FINAL>
__device__ __forceinline__ void panel_norm(CArgs& a, unsigned char* lds, int l, int which, int pm, int quarter) {
    const int tid = threadIdx.x, lane = tid & 63, wave = tid >> 6;
    float* X = a.ph_hi >= 1000 ? (float*)(a.ws + WS_PROJ) : a.out; bf16* U = (bf16*)(a.ws + WS_U); float* GT = (float*)(a.ws + WS_GATES);
    float* wg = (float*)lds;
    if (GATES) {
        const float* W = a.in[I_WIN] + (size_t)l * 1024 * NIN + NPROJ;
        for (int i = tid; i < 4096; i += 512) { const int k = i >> 2, j4 = i & 3; const f32x4 v = *(const f32x4*)(W + (size_t)k * NIN + 4 * j4);
            wg[(4 * j4 + 0) * 1024 + k] = v.x; wg[(4 * j4 + 1) * 1024 + k] = v.y; wg[(4 * j4 + 2) * 1024 + k] = v.z; wg[(4 * j4 + 3) * 1024 + k] = v.w; }
        __syncthreads();
    }
    const int kind = pm < 32 ? 0 : 1 + ((pm - 32) >> 2);
    const float* gvec = FINAL ? a.in[I_NFG] : (which == 1 ? a.in[I_N1G] + l * 1024 : a.in[I_N2G] + l * 1024);
    const float* sh = (const float*)(a.ws + WS_MOD) + (size_t)l * 3 * 6144 + kind * 6144 + (which == 1 ? 0 : 3072); const float* sc = sh + 1024;
    f32x4 gs[4], s0[4];
#pragma unroll
    for (int j = 0; j < 4; ++j) { const int c = 4 * lane + 256 * j; gs[j] = *(const f32x4*)(gvec + c);
        if (!FINAL) { gs[j] = gs[j] * (*(const f32x4*)(sc + c) + 1.0f); s0[j] = *(const f32x4*)(sh + c); } else s0[j] = (f32x4){0.f, 0.f, 0.f, 0.f}; }
    float gb = 0.f; if (GATES) gb = a.in[I_MLGB][l * 16 + ((lane >> 5) & 1) * 8 + ((lane >> 4) & 1) * 4 + ((lane >> 3) & 1) * 2 + ((lane >> 2) & 1)];
    const int rbase = pm * 256 + quarter * 64 + wave * 8;
    constexpr int NB = GATES ? 1 : 8;
#pragma unroll 1
    for (int b = 0; b < 8 / NB; ++b) {
        f32x4 vv[NB][4];
#pragma unroll
        for (int k = 0; k < NB; ++k)
#pragma unroll
            for (int j = 0; j < 4; ++j) vv[k][j] = *(const f32x4*)(X + (size_t)(rbase + NB * b + k) * D + 4 * lane + 256 * j);
#pragma unroll
        for (int k = 0; k < NB; ++k) { const int r = rbase + NB * b + k;
            float ss = 0.f;
#pragma unroll
            for (int j = 0; j < 4; ++j) ss += (vv[k][j].x * vv[k][j].x + vv[k][j].y * vv[k][j].y) + (vv[k][j].z * vv[k][j].z + vv[k][j].w * vv[k][j].w);
            const float rstd = 1.0f / sqrtf(wave_sum(ss) * (1.0f / D) + EPS);
            f32x4 v[4];
#pragma unroll
            for (int j = 0; j < 4; ++j) { v[j] = vv[k][j] * rstd * gs[j] + s0[j];
                if (FINAL) *(f32x4*)(X + (size_t)r * D + 4 * lane + 256 * j) = v[j];
                else { u32x2 o; o.x = cvtpk(v[j].x, v[j].y); o.y = cvtpk(v[j].z, v[j].w); *(u32x2*)(U + (size_t)r * D + 4 * lane + 256 * j) = o; } }
            if (GATES) { float p[16];
#pragma unroll
                for (int g = 0; g < 16; ++g) p[g] = 0.f;
#pragma unroll
                for (int j = 0; j < 4; ++j) {
#pragma unroll
                    for (int g = 0; g < 8; ++g) { const f32x4 w = *(const f32x4*)(wg + g * 1024 + 4 * lane + 256 * j); p[g] += (v[j].x * w.x + v[j].y * w.y) + (v[j].z * w.z + v[j].w * w.w); }
                    __builtin_amdgcn_sched_barrier(0);
#pragma unroll
                    for (int g = 8; g < 16; ++g) { const f32x4 w = *(const f32x4*)(wg + g * 1024 + 4 * lane + 256 * j); p[g] += (v[j].x * w.x + v[j].y * w.y) + (v[j].z * w.z + v[j].w * w.w); }
                    __builtin_amdgcn_sched_barrier(0); }
                const float tot = fold16(p, lane);
                if ((lane & 3) == 0) GT[(size_t)r * 16 + ((lane >> 5) & 1) * 8 + ((lane >> 4) & 1) * 4 + ((lane >> 3) & 1) * 2 + ((lane >> 2) & 1)] = tot + gb; }
        }
    }
}
template <bool GATES, bool FINAL>
__device__ __forceinline__ void panel_tail(CArgs& a, unsigned char* lds, int l, int which, unsigned* cnt_bank, const pg8::StaticOrder& S) {
    pg8::Unit u; if (!first_unit(NTOK / 256, 4, (int)blockIdx.x, u)) return;
    if (threadIdx.x == 0) {
        __builtin_amdgcn_fence(__ATOMIC_RELEASE, "agent");
        asm volatile("s_waitcnt vmcnt(0)" ::: "memory");
        unsigned* c = cnt_bank + 64 * u.pm;
        (void)__hip_atomic_fetch_add(c, 1u, __ATOMIC_RELAXED, __HIP_MEMORY_SCOPE_AGENT);
        unsigned spins = 0;
        while (__hip_atomic_load(c, __ATOMIC_RELAXED, __HIP_MEMORY_SCOPE_AGENT) < 4u && ++spins < (1u << 22)) __builtin_amdgcn_s_sleep(1);
        __builtin_amdgcn_fence(__ATOMIC_ACQUIRE, "agent"); asm volatile("s_waitcnt vmcnt(0)" ::: "memory");
    }
    __syncthreads();
    panel_norm<GATES, FINAL>(a, lds, l, which, u.pm, u.pn);
}

__device__ __forceinline__ float conv3_at(const bf16* base, int ld, int t, int L, int col, float w0, float w1, float w2) {
    float r = w1 * bflo(base[(size_t)t * ld + col]);
    if (t > 0) r += w0 * bflo(base[(size_t)(t - 1) * ld + col]);
    if (t < L - 1) r += w2 * bflo(base[(size_t)(t + 1) * ld + col]);
    return r;
}

__device__ __forceinline__ void sc_item(CArgs& a, int l, int item) {
    const bf16* P = (const bf16*)(a.ws + WS_PROJ); bf16* Y = (bf16*)(a.ws + WS_Y);
    const int idx = item * 512 + opaque_tid();
    const int tok = idx >> 5, c0 = (idx & 31) * 8;
    const int t = tok < NPT ? (tok & 255) : ((tok - NPT) & 1023), L = tok < NPT ? LP : LS;
    const float* w = a.in[I_SCW] + l * 3 * 256;
    float bg[8], cx[3][8];
    unpack8(ld8(P + (size_t)tok * PLD + c0), bg);
#pragma unroll
    for (int j = 0; j < 3; ++j) { const int tt = t + j - 1; const bool ok = tt >= 0 && tt < L; const int tk = ok ? tok + j - 1 : tok;
        float cgv[8], xi[8]; unpack8(ld8(P + (size_t)tk * PLD + 256 + c0), cgv); unpack8(ld8(P + (size_t)tk * PLD + 512 + c0), xi);
#pragma unroll
        for (int e = 0; e < 8; ++e) cx[j][e] = ok ? cgv[e] * xi[e] : 0.f; }
    float y[8];
#pragma unroll
    for (int e = 0; e < 8; ++e) y[e] = bg[e] * (w[c0 + e] * cx[0][e] + w[256 + c0 + e] * cx[1][e] + w[512 + c0 + e] * cx[2][e]);
    u32x4 o; o.x = pk2(y[0], y[1]); o.y = pk2(y[2], y[3]); o.z = pk2(y[4], y[5]); o.w = pk2(y[6], y[7]);
    *(u32x4*)(Y + (size_t)tok * D + c0) = o;
}

typedef short bf16x8 __attribute__((ext_vector_type(8)));
typedef short s16x4 __attribute__((ext_vector_type(4)));
typedef float f32x16 __attribute__((ext_vector_type(16)));
#define MFMA32(a, b, c) __builtin_amdgcn_mfma_f32_32x32x16_bf16((a), (b), (c), 0, 0, 0)
template <int S> __device__ __forceinline__ bf16x8 pack8(const f32x16& x) { u32x4 p; p.x = cvtpk(x[8 * S], x[8 * S + 1]); p.y = cvtpk(x[8 * S + 2], x[8 * S + 3]); p.z = cvtpk(x[8 * S + 4], x[8 * S + 5]); p.w = cvtpk(x[8 * S + 6], x[8 * S + 7]); return __builtin_bit_cast(bf16x8, p); }
__device__ __forceinline__ int tswz(int row, int blk) { return row * 72 + ((blk ^ ((row >> 3) & 7)) << 3); }
__device__ __forceinline__ bf16x8 perm_frag(const bf16x8 f) { u32x4 u = __builtin_bit_cast(u32x4, f); const auto p = __builtin_amdgcn_permlane32_swap(u.x, u.z, false, false), q = __builtin_amdgcn_permlane32_swap(u.y, u.w, false, false);
    u.x = p[0]; u.z = p[1]; u.y = q[0]; u.w = q[1]; return __builtin_bit_cast(bf16x8, u); }
__device__ __forceinline__ bf16x8 join8(s16x4 lo, s16x4 hi) { return __builtin_shufflevector(lo, hi, 0, 1, 2, 3, 4, 5, 6, 7); }

template <int VAR> __device__ __forceinline__ void mlstm_item_mfma(CArgs& a, unsigned char* lds, int l, int item) {
    const int tid = opaque_tid(), lane = tid & 63, wave = __builtin_amdgcn_readfirstlane(tid >> 6), dvb = wave & 3, tb = wave >> 2, r = lane & 31, h = lane >> 5;
    int seq, hd;
    if (item < 16) { seq = 32 + item / 8; hd = item % 8; } else { const int it = item - 16; seq = it / 8; hd = it % 8; }
    const int head = hd >> 1, dir = hd & 1, L = seq < 32 ? LP : LS, tok0 = seq < 32 ? seq * 256 : NPT + (seq - 32) * 1024, nc = L >> 6;
    bf16* Qp = (bf16*)lds; bf16* Kp = (bf16*)(lds + 17408); bf16* KwT = (bf16*)(lds + 34816); bf16* VT = (bf16*)(lds + 53248);
    float* gA = (float*)(lds + 71680); float* gM = gA + 1024; float* gWp = gM + 1024; float* gEm = gWp + 1024; float* gWs = gEm + 1024;
    float* gWc = (float*)(lds + 92160); float* nS0 = gWc + 128; float* cwS = nS0 + 256; float* qnS = cwS + 768;
    const bf16* P = (const bf16*)(a.ws + WS_PROJ) + (size_t)tok0 * PLD + ML_OFF;
    const float* GT = (const float*)(a.ws + WS_GATES) + (size_t)tok0 * 16;
    bf16* HO = (bf16*)(a.ws + (VAR ? (dir ? (234u << 20) : (224u << 20)) : (dir ? WS_HB : WS_HF))) + (size_t)tok0 * 512 + head * 128;
    const float* cw = a.in[I_MLCW] + l * 3 * 1024;
    const size_t sidx = seq >= 32 ? ((((size_t)(seq - 32) * 2 + l) * 2 + dir) * 4 + head) : ((((size_t)seq * 2 + l) * 2 + dir) * 4 + head);
    __syncthreads();
    for (int i = tid; i < 768; i += 512) { const int j = i >> 8, c = i & 255; cwS[i] = cw[j * 1024 + (c < 128 ? head * 128 + c : 512 + head * 128 + (c - 128))]; }
    if (tid < 128) nS0[tid] = seq >= 32 ? a.in[I_SN][sidx * 128 + tid] : 0.f;
    for (int t = tid; t < L; t += 512) { gA[t] = GT[(size_t)t * 16 + dir * 8 + head]; gM[t] = GT[(size_t)t * 16 + dir * 8 + 4 + head]; }
    __syncthreads();
    float* sAl = gWc + 64; float* sBl = sAl + 16; float* sMp = sBl + 16; float* sMf = sMp + 16; float* sWa = gWc + 32;
    for (int ci = wave; ci < nc; ci += 8) {
        const int c = dir ? nc - 1 - ci : ci, s = dir ? 63 - lane : lane, t = 64 * c + s;
        const float ip = gA[t], fp = gM[t];
        const float lf = fminf(fp, 0.f) - __logf(1.f + __expf(-fabsf(fp)));
        float b = lf;
#pragma unroll
        for (int o = 1; o < 64; o <<= 1) { const float x = __shfl_up(b, o); if (lane >= o) b += x; }
        const float av = ip - b; float cm = av;
#pragma unroll
        for (int o = 1; o < 64; o <<= 1) { const float x = __shfl_up(cm, o); if (lane >= o) cm = fmaxf(cm, x); }
        gA[t] = av; gM[t] = cm; gEm[t] = b;
        if (lane == 63) { sAl[ci] = cm; sBl[ci] = b; }
    }
    __syncthreads();
    if (tid == 0) { float mprev = seq >= 32 ? a.in[I_SM][sidx] : 0.f;
        for (int ci = 0; ci < nc; ++ci) { const float Mf = fmaxf(mprev, sAl[ci]); sMp[ci] = mprev; sMf[ci] = Mf; gWc[ci] = __expf(mprev - Mf); sWa[ci] = __expf(fminf(mprev - sAl[ci], 80.f)); mprev = sBl[ci] + Mf; }
        gWc[16] = mprev; }
    __syncthreads();
    for (int t = tid; t < L; t += 512) { const int c = t >> 6, ci = dir ? nc - 1 - c : c; const float mprev = sMp[ci], Mf = sMf[ci];
        const float av = gA[t], b = gEm[t], M = fmaxf(mprev, gM[t]);
        const float Al = sAl[ci];
        gA[t] = __expf(av - Al); gWp[t] = __expf(fminf(Al - M, 80.f)); gEm[t] = __expf(-(b + M)); gWs[t] = __expf(av - Mf); }
    f32x16 Ct[4];
    if (seq >= 32) { const float* C0 = a.in[I_SC] + sidx * 16384;
#pragma unroll
        for (int dkb = 0; dkb < 4; ++dkb)
#pragma unroll
            for (int i = 0; i < 16; ++i) Ct[dkb][i] = C0[(size_t)(32 * dkb + (i & 3) + 8 * (i >> 2) + 4 * h) * 128 + 32 * dvb + r]; }
    else {
#pragma unroll
        for (int dkb = 0; dkb < 4; ++dkb)
#pragma unroll
            for (int i = 0; i < 16; ++i) Ct[dkb][i] = 0.f; }
    __syncthreads();
    const float kscale = 0.08838834764831845f;
    const int tl = 32 * tb + r;
    const int sp = tid >> 4, g8 = (tid & 15) * 8;
    u32x4 Rq[4], Rk[4], Rv[2];
#define ML_ISSUE(CI) do { const int c_ = dir ? nc - 1 - (CI) : (CI); const int t0_ = 64 * c_ + 2 * sp; \
        _Pragma("unroll") for (int j = 0; j < 4; ++j) { int tt = t0_ + j - 1; tt = tt < 0 ? 0 : (tt > L - 1 ? L - 1 : tt); \
            Rq[j] = ld8(P + (size_t)tt * PLD + head * 128 + g8); Rk[j] = ld8(P + (size_t)tt * PLD + 512 + head * 128 + g8); } \
        Rv[0] = ld8(P + (size_t)t0_ * PLD + 1024 + head * 128 + g8); Rv[1] = ld8(P + (size_t)(t0_ + 1) * PLD + 1024 + head * 128 + g8); } while (0)
    ML_ISSUE(0);
#pragma unroll 1
    for (int ci = 0; ci < nc; ++ci) {
        const int c = dir ? nc - 1 - ci : ci, tc0 = 64 * c;
        const float* nS = nS0 + 128 * (ci & 1); float* nSn = nS0 + 128 * ((ci + 1) & 1);
        if (VAR != 1) { const int s0 = 2 * sp, t0 = tc0 + s0;
          const float mlo = t0 > 0 ? 1.f : 0.f, mhi = (t0 + 2 < L) ? 1.f : 0.f;
          float qa[4][8], ka[4][8], q0[8], q1[8], k0[8], k1[8], v0[8], v1[8];
#pragma unroll
          for (int j = 0; j < 4; ++j) { unpack8(Rq[j], qa[j]); unpack8(Rk[j], ka[j]); }
          unpack8(Rv[0], v0); unpack8(Rv[1], v1);
#pragma unroll
          for (int e = 0; e < 8; ++e) { const float a0 = cwS[g8 + e], a1 = cwS[256 + g8 + e], a2 = cwS[512 + g8 + e], b0 = cwS[128 + g8 + e], b1 = cwS[384 + g8 + e], b2 = cwS[640 + g8 + e];
              const float x0 = a0 * mlo * qa[0][e] + a1 * qa[1][e] + a2 * qa[2][e], x1 = a0 * qa[1][e] + a1 * qa[2][e] + a2 * mhi * qa[3][e];
              const float y0 = b0 * mlo * ka[0][e] + b1 * ka[1][e] + b2 * ka[2][e], y1 = b0 * ka[1][e] + b1 * ka[2][e] + b2 * mhi * ka[3][e];
              q0[e] = x0 * __builtin_amdgcn_rcpf(1.f + __expf(-x0)); q1[e] = x1 * __builtin_amdgcn_rcpf(1.f + __expf(-x1));
              k0[e] = y0 * kscale * __builtin_amdgcn_rcpf(1.f + __expf(-y0)); k1[e] = y1 * kscale * __builtin_amdgcn_rcpf(1.f + __expf(-y1)); }
          u32x4 o; o.x = cvtpk(q0[0], q0[1]); o.y = cvtpk(q0[2], q0[3]); o.z = cvtpk(q0[4], q0[5]); o.w = cvtpk(q0[6], q0[7]); *(u32x4*)(Qp + s0 * 136 + g8) = o;
          o.x = cvtpk(q1[0], q1[1]); o.y = cvtpk(q1[2], q1[3]); o.z = cvtpk(q1[4], q1[5]); o.w = cvtpk(q1[6], q1[7]); *(u32x4*)(Qp + (s0 + 1) * 136 + g8) = o;
          o.x = cvtpk(k0[0], k0[1]); o.y = cvtpk(k0[2], k0[3]); o.z = cvtpk(k0[4], k0[5]); o.w = cvtpk(k0[6], k0[7]); *(u32x4*)(Kp + s0 * 136 + g8) = o;
          o.x = cvtpk(k1[0], k1[1]); o.y = cvtpk(k1[2], k1[3]); o.z = cvtpk(k1[4], k1[5]); o.w = cvtpk(k1[6], k1[7]); *(u32x4*)(Kp + (s0 + 1) * 136 + g8) = o;
          { const f32x4 n0 = *(const f32x4*)(nS + g8), n1 = *(const f32x4*)(nS + g8 + 4);
            float p0 = (q0[0] * n0.x + q0[1] * n0.y) + (q0[2] * n0.z + q0[3] * n0.w) + (q0[4] * n1.x + q0[5] * n1.y) + (q0[6] * n1.z + q0[7] * n1.w);
            float p1 = (q1[0] * n0.x + q1[1] * n0.y) + (q1[2] * n0.z + q1[3] * n0.w) + (q1[4] * n1.x + q1[5] * n1.y) + (q1[6] * n1.z + q1[7] * n1.w);
            p0 = DPP_ADD(p0, 0xB1); p1 = DPP_ADD(p1, 0xB1); p0 = DPP_ADD(p0, 0x4E); p1 = DPP_ADD(p1, 0x4E); p0 = DPP_ADD(p0, 0x141); p1 = DPP_ADD(p1, 0x141); p0 = DPP_ADD(p0, 0x140); p1 = DPP_ADD(p1, 0x140);
            if ((tid & 15) == 0) { qnS[s0] = p0; qnS[s0 + 1] = p1; } }
          const float ws0 = gWs[t0], ws1 = gWs[t0 + 1];
#pragma unroll
          for (int e = 0; e < 8; ++e) { const int off = tswz(g8 + e, s0 >> 3) + (s0 & 7); *(unsigned*)(KwT + off) = cvtpk(k0[e] * ws0, k1[e] * ws1); *(unsigned*)(VT + off) = cvtpk(v0[e], v1[e]); } }
        if (ci + 1 < nc) ML_ISSUE(ci + 1);
        __syncthreads();
        const bool skip0 = dir && tb, skip1 = !dir && !tb;
        f32x16 ST0, ST1, acc;
#pragma unroll
        for (int i = 0; i < 16; ++i) { ST0[i] = 0.f; ST1[i] = 0.f; acc[i] = 0.f; }
        float dsum = 0.f; bf16x8 vt[4];
        const float ex = gWp[tc0 + tl], em = gEm[tc0 + tl], pq = qnS[tl], wa = sWa[ci];
#pragma unroll
        for (int k4 = 0; k4 < 4; ++k4) vt[k4] = *(const bf16x8*)(VT + tswz(32 * dvb + r, 2 * k4 + h));
        if (VAR != 2) {
#define LDQ(KK) (*(const bf16x8*)(Qp + tl * 136 + 16 * (KK) + 8 * h))
#define LDK0(KK) (*(const bf16x8*)(Kp + r * 136 + 16 * (KK) + 8 * h))
#define LDK1(KK) (*(const bf16x8*)(Kp + (32 + r) * 136 + 16 * (KK) + 8 * h))
#define ST_STEP(KK, DKB, K2, SK0, SK1) { bf16x8 bqn = bq, a0n = a0, a1n = a1; \
            if ((KK) < 7) { bqn = LDQ((KK) + 1); if (!(SK0)) a0n = LDK0((KK) + 1); if (!(SK1)) a1n = LDK1((KK) + 1); } \
            if (!(SK0)) ST0 = MFMA32(a0, bq, ST0); if (!(SK1)) ST1 = MFMA32(a1, bq, ST1); \
            acc = MFMA32(pack8<K2>(Ct[DKB]), perm_frag(bq), acc); \
            __builtin_amdgcn_sched_barrier(0); bq = bqn; a0 = a0n; a1 = a1n; }
#define ST_ALL(SK0, SK1) { bf16x8 bq = LDQ(0), a0 = bq, a1 = bq; if (!(SK0)) a0 = LDK0(0); if (!(SK1)) a1 = LDK1(0); \
            ST_STEP(0, 0, 0, SK0, SK1) ST_STEP(1, 0, 1, SK0, SK1) ST_STEP(2, 1, 0, SK0, SK1) ST_STEP(3, 1, 1, SK0, SK1) ST_STEP(4, 2, 0, SK0, SK1) ST_STEP(5, 2, 1, SK0, SK1) ST_STEP(6, 3, 0, SK0, SK1) ST_STEP(7, 3, 1, SK0, SK1) }
        if (skip0) ST_ALL(1, 0) else if (skip1) ST_ALL(0, 1) else ST_ALL(0, 0)
#undef ST_ALL
#undef ST_STEP
#undef LDQ
#undef LDK0
#undef LDK1
#pragma unroll
        for (int i = 0; i < 16; ++i) { const int s0 = (i & 3) + 8 * (i >> 2) + 4 * h, s1 = 32 + s0;
            const float e0 = gA[tc0 + s0], e1 = gA[tc0 + s1];
            const bool v0 = tb ? true : (dir ? (s0 >= tl) : (s0 <= tl)), v1 = tb ? (dir ? (s1 >= tl) : (s1 <= tl)) : true;
            ST0[i] = v0 ? ST0[i] * e0 : 0.f; ST1[i] = v1 ? ST1[i] * e1 : 0.f; dsum += ST0[i] + ST1[i]; }
        dsum += __shfl_xor(dsum, 32);
#pragma unroll
        for (int i = 0; i < 16; ++i) acc[i] *= wa;
        if (!skip0) { acc = MFMA32(perm_frag(vt[0]), pack8<0>(ST0), acc); acc = MFMA32(perm_frag(vt[1]), pack8<1>(ST0), acc); }
        if (!skip1) { acc = MFMA32(perm_frag(vt[2]), pack8<0>(ST1), acc); acc = MFMA32(perm_frag(vt[3]), pack8<1>(ST1), acc); }
        }
        { const float den = ex * (dsum + wa * pq), inv = ex / fmaxf(fabsf(den), em);
          bf16* hp = HO + (size_t)(tc0 + tl) * 512 + 32 * dvb + 4 * h;
#pragma unroll
          for (int g4 = 0; g4 < 4; ++g4) { u32x2 o; o.x = cvtpk(acc[4 * g4] * inv, acc[4 * g4 + 1] * inv); o.y = cvtpk(acc[4 * g4 + 2] * inv, acc[4 * g4 + 3] * inv); *(u32x2*)(hp + 8 * g4) = o; } }
        { const float wc = gWc[ci];
#pragma unroll
          for (int dkb = 0; dkb < 4; ++dkb)
#pragma unroll
              for (int i = 0; i < 16; ++i) Ct[dkb][i] *= wc;
          if (VAR != 3)
#pragma unroll
          for (int k4 = 0; k4 < 4; ++k4) { const bf16x8 bv = vt[k4];
#pragma unroll
              for (int dkb = 0; dkb < 4; ++dkb) { const bf16x8 ak = *(const bf16x8*)(KwT + tswz(32 * dkb + r, 2 * k4 + h)); Ct[dkb] = MFMA32(ak, bv, Ct[dkb]); } }
          if (tid < 128) { float sn = 0.f;
#pragma unroll
              for (int j = 0; j < 8; ++j) { float k8[8]; unpack8(*(const u32x4*)(KwT + tid * 72 + 8 * j), k8); sn += ((k8[0] + k8[1]) + (k8[2] + k8[3])) + ((k8[4] + k8[5]) + (k8[6] + k8[7])); }
              nSn[tid] = wc * nS[tid] + sn; } }
        __syncthreads();
    }
#undef ML_ISSUE
    if (VAR == 0 && seq < 32 && a.ph_hi < 1000) {
        float* Co = a.out + OUT_C + sidx * 16384;
        if (tb == 0) {
#pragma unroll
            for (int dkb = 0; dkb < 4; ++dkb)
#pragma unroll
                for (int i = 0; i < 16; ++i) Co[(size_t)(32 * dkb + (i & 3) + 8 * (i >> 2) + 4 * h) * 128 + 32 * dvb + r] = Ct[dkb][i]; }
        if (tid < 128) a.out[OUT_N + sidx * 128 + tid] = nS0[128 * (nc & 1) + tid];
        if (tid == 0) a.out[OUT_M + sidx] = gWc[16]; }
}


__device__ __forceinline__ f32x4 conv4(const bf16* row, int t, int L, float w0, float w1, float w2) {
    const u32x2 m = *(const u32x2*)(row + t);
    const float x0 = bflo(m.x), x1 = bfhi(m.x), x2 = bflo(m.y), x3 = bfhi(m.y);
    const unsigned rm = row[t > 0 ? t - 1 : t], rp = row[(t + 4 < L) ? t + 4 : t];
    const float xm = t > 0 ? bflo(rm) : 0.f, xp = (t + 4 < L) ? bflo(rp) : 0.f;
    return (f32x4){w0 * xm + w1 * x0 + w2 * x1, w0 * x0 + w1 * x1 + w2 * x2, w0 * x1 + w1 * x2 + w2 * x3, w0 * x2 + w1 * x3 + w2 * xp};
}
struct Raw4 { u32x2 m; unsigned nb; };
__device__ __forceinline__ Raw4 conv4_load(const bf16* row, int t, int L) { Raw4 q; q.m = *(const u32x2*)(row + t); const unsigned rm = row[t > 0 ? t - 1 : t], rp = row[(t + 4 < L) ? t + 4 : t]; q.nb = rm | (rp << 16); return q; }
__device__ __forceinline__ f32x4 conv4_eval(const Raw4 q, int t, int L, float w0, float w1, float w2) {
    const float x0 = bflo(q.m.x), x1 = bfhi(q.m.x), x2 = bflo(q.m.y), x3 = bfhi(q.m.y);
    const float xm = t > 0 ? bflo(q.nb) : 0.f, xp = (t + 4 < L) ? bfhi(q.nb) : 0.f;
    return (f32x4){w0 * xm + w1 * x0 + w2 * x1, w0 * x0 + w1 * x1 + w2 * x2, w0 * x1 + w1 * x2 + w2 * x3, w0 * x2 + w1 * x3 + w2 * xp};
}
template <int L> __device__ __forceinline__ bf16x8 toep_frag(const bf16* Fw, int base) {
    const int kb = L - base;
    const unsigned* p = (const unsigned*)((kb & 1) ? Fw + 2 * L + (kb - 1) : Fw + kb);
    u32x4 f; f.x = p[0]; f.y = p[1]; f.z = p[4]; f.w = p[5];
    return __builtin_bit_cast(bf16x8, f);
}
__device__ __forceinline__ bf16x8 pack_f8(const f32x4 lo, const f32x4 hi) { u32x4 p; p.x = cvtpk(lo.x, lo.y); p.y = cvtpk(lo.z, lo.w); p.z = cvtpk(hi.x, hi.y); p.w = cvtpk(hi.z, hi.w); return __builtin_bit_cast(bf16x8, p); }
template <int L> __device__ __forceinline__ void hy_load_filter(const float* Gc, bf16* Fw, int lane) {
    constexpr int NIT = 2 * L / 128;
    float sa = 0.f;
#pragma unroll 8
    for (int e = 0; e < NIT; ++e) { const int j = e * 128 + 2 * lane; const f32x2_t x = *(const f32x2_t*)(Gc + j); sa += ((j == 0) ? 0.f : fabsf(x.x)) + fabsf(x.y); }
    sa = wave_sum(sa); const float inv = 1.0f / sa;
#pragma unroll 8
    for (int e = 0; e < NIT; ++e) { const int k = e * 128 + 2 * lane;
        const int j2 = 2 * L - k - 2; const f32x2_t x = *(const f32x2_t*)(Gc + (j2 >= 0 ? j2 : 0)); const float top = Gc[k > 0 ? 2 * L - k : 1];
        const float r0 = k > 0 ? top * inv : 0.f, r1 = x.y * inv, r2 = (j2 > 0) ? x.x * inv : 0.f;
        *(unsigned*)(Fw + k) = cvtpk(r0, r1); *(unsigned*)(Fw + 2 * L + k) = cvtpk(r1, r2); }
}
#define HY_WAVE_SYNC() do { asm volatile("s_waitcnt lgkmcnt(0)" ::: "memory"); __builtin_amdgcn_wave_barrier(); } while (0)

__device__ __forceinline__ void hyena_prompt_wave(CArgs& a, unsigned char* wlds, int l, int c) {
    const int lane = opaque_tid() & 63, r = lane & 31, h = lane >> 5;
    bf16* Fw = (bf16*)wlds;
    bf16x8* Zs = (bf16x8*)(wlds + 2048);
    const float* Gf = (const float*)(a.ws + WS_FILT) + (size_t)l * FILT_L;
    const bf16* HYT = (const bf16*)(a.ws + WS_HYT); bf16* YHT = (bf16*)(a.ws + WS_YHT);
    const float* cw = a.in[I_HYCW] + l * 3 * 768;
    const bf16* vrow = HYT + (size_t)c * NTOK + r * 256; const bf16* g1row = HYT + (size_t)(256 + c) * NTOK + r * 256; const bf16* g2row = HYT + (size_t)(512 + c) * NTOK + r * 256;
    const float vw0 = cw[c], vw1 = cw[768 + c], vw2 = cw[1536 + c];
    const float sk0 = a.in[I_HSKIP][l * 512 + c], sk1 = a.in[I_HSKIP][l * 512 + 256 + c];
    bf16x8 zf[16];
    { Raw4 zr[32];
#pragma unroll
      for (int ss = 0; ss < 16; ++ss) { zr[2 * ss] = conv4_load(vrow, 16 * ss + 4 * h, 256); zr[2 * ss + 1] = conv4_load(vrow, 16 * ss + 8 + 4 * h, 256); }
#pragma unroll
      for (int ss = 0; ss < 16; ++ss) zf[ss] = pack_f8(conv4_eval(zr[2 * ss], 16 * ss + 4 * h, 256, vw0, vw1, vw2), conv4_eval(zr[2 * ss + 1], 16 * ss + 8 + 4 * h, 256, vw0, vw1, vw2)); }
#pragma unroll 1
    for (int o = 0; o < 2; ++o) {
        HY_WAVE_SYNC();
        hy_load_filter<256>(Gf + (size_t)(o * 256 + c) * 512, Fw, lane);
        HY_WAVE_SYNC();
        const bf16* F = Fw;
        const bf16* grow = o ? g2row : g1row; const int gch = 256 * (o + 1) + c;
        const float gw0 = cw[gch], gw1 = cw[768 + gch], gw2 = cw[1536 + gch], sk = o ? sk1 : sk0;
#pragma unroll
        for (int half = 0; half < 2; ++half) {
            f32x16 acc[4];
#pragma unroll
            for (int q = 0; q < 4; ++q)
#pragma unroll
                for (int i = 0; i < 16; ++i) acc[q][i] = 0.f;
            Raw4 graw[4][4];
#pragma unroll
            for (int Tl = 0; Tl < 4; ++Tl)
#pragma unroll
                for (int g = 0; g < 4; ++g) graw[Tl][g] = conv4_load(grow, 32 * (4 * half + Tl) + 8 * g + 4 * h, 256);
            const int fb = 128 * half + r - 4 * h;
#pragma unroll
            for (int par = 0; par < 2; ++par) {
                bf16x8 A0 = toep_frag<256>(F, fb - 16 * par), A1 = toep_frag<256>(F, fb + 32 - 16 * par), A2 = toep_frag<256>(F, fb + 64 - 16 * par), A3 = toep_frag<256>(F, fb + 96 - 16 * par);
#pragma unroll
                for (int q = 0; q < 8; ++q) { const int ss = 2 * q + par;
                    acc[0] = MFMA32(A0, zf[ss], acc[0]); acc[1] = MFMA32(A1, zf[ss], acc[1]); acc[2] = MFMA32(A2, zf[ss], acc[2]); acc[3] = MFMA32(A3, zf[ss], acc[3]);
                    if (q < 7) { A3 = A2; A2 = A1; A1 = A0; A0 = toep_frag<256>(F, fb - 16 * (ss + 2)); } }
            }
#pragma unroll
            for (int Tl = 0; Tl < 4; ++Tl) { const int T = 4 * half + Tl;
                f32x16 zn;
#pragma unroll
                for (int g = 0; g < 4; ++g) { const f32x4 gt = conv4_eval(graw[Tl][g], 32 * T + 8 * g + 4 * h, 256, gw0, gw1, gw2);
                    const bf16x8 zz = zf[2 * T + (g >> 1)]; const u32x4 zu = __builtin_bit_cast(u32x4, zz);
                    const unsigned w0 = (g & 1) ? zu.z : zu.x, w1 = (g & 1) ? zu.w : zu.y;
                    zn[4 * g + 0] = gt.x * (acc[Tl][4 * g + 0] + sk * bflo(w0)); zn[4 * g + 1] = gt.y * (acc[Tl][4 * g + 1] + sk * bfhi(w0));
                    zn[4 * g + 2] = gt.z * (acc[Tl][4 * g + 2] + sk * bflo(w1)); zn[4 * g + 3] = gt.w * (acc[Tl][4 * g + 3] + sk * bfhi(w1)); }
                if (o == 0) { Zs[(2 * T) * 64 + lane] = pack8<0>(zn); Zs[(2 * T + 1) * 64 + lane] = pack8<1>(zn); }
                else { bf16* yp = YHT + (size_t)c * NTOK + r * 256 + 32 * T + 4 * h;
#pragma unroll
                    for (int g = 0; g < 4; ++g) { u32x2 ov; ov.x = cvtpk(zn[4 * g], zn[4 * g + 1]); ov.y = cvtpk(zn[4 * g + 2], zn[4 * g + 3]); *(u32x2*)(yp + 8 * g) = ov; } }
            }
        }
        if (o == 0) { HY_WAVE_SYNC();
#pragma unroll
            for (int ss = 0; ss < 16; ++ss) zf[ss] = Zs[ss * 64 + lane]; }
    }
}

__device__ __forceinline__ void hyena_sample_wave(CArgs& a, unsigned char* wlds, int l, int c) {
    const int lane = opaque_tid() & 63, r = lane & 31, h = lane >> 5;
    bf16* Fw = (bf16*)wlds;
    bf16* zb = (bf16*)(wlds + 8192);
    constexpr int ZSTR = 36, ZB1 = 32 * ZSTR, ZOFF = 2 * ZB1;
    const float* Gf = (const float*)(a.ws + WS_FILT) + (size_t)l * FILT_L + 262144;
    const bf16* HYT = (const bf16*)(a.ws + WS_HYT); bf16* YHT = (bf16*)(a.ws + WS_YHT);
    const float* cw = a.in[I_HYCW] + l * 3 * 768;
    HY_WAVE_SYNC();
    const bf16* vrow = HYT + (size_t)c * NTOK + NPT;
    { const float vw0 = cw[c], vw1 = cw[768 + c], vw2 = cw[1536 + c];
#pragma unroll
      for (int it = 0; it < 8; ++it) { const int idx = it * 64 + lane, nb = idx >> 8, t = (idx & 255) * 4;
          const f32x4 z = conv4(vrow + nb * 1024, t, 1024, vw0, vw1, vw2); u32x2 o; o.x = cvtpk(z.x, z.y); o.y = cvtpk(z.z, z.w); *(u32x2*)(zb + nb * ZB1 + (t >> 5) * ZSTR + (t & 31)) = o; } }
    if (lane < 24) *(unsigned*)(zb + ZOFF + 2 * lane) = 0u;
    HY_WAVE_SYNC();
#pragma unroll 1
    for (int o = 0; o < 2; ++o) {
        hy_load_filter<1024>(Gf + (size_t)(o * 256 + c) * 2048, Fw, lane);
        HY_WAVE_SYNC();
        const bf16* F = Fw;
        const int gch = 256 * (o + 1) + c; const bf16* grow = HYT + (size_t)gch * NTOK + NPT;
        const float gw0 = cw[gch], gw1 = cw[768 + gch], gw2 = cw[1536 + gch], sk = a.in[I_HSKIP][l * 512 + o * 256 + c];
        f32x16 acc0, acc1;
#pragma unroll
        for (int i = 0; i < 16; ++i) { acc0[i] = 0.f; acc1[i] = 0.f; }
#pragma unroll 1
        for (int dl = -31; dl <= 31; ++dl) { const int seg = r - dl; const bool valid = seg >= 0 && seg < 32; const int so = valid ? ZSTR * seg + 4 * h : ZOFF + 4 * h, so1 = valid ? ZB1 + ZSTR * seg + 4 * h : ZOFF + 4 * h;
#pragma unroll
            for (int kk = 0; kk < 2; ++kk) { const bf16x8 A = toep_frag<1024>(F, 32 * dl - 16 * kk + r - 4 * h);
                const s16x4 l0 = *(const s16x4*)(zb + so + 16 * kk), h0 = *(const s16x4*)(zb + so + 16 * kk + 8), l1 = *(const s16x4*)(zb + so1 + 16 * kk), h1 = *(const s16x4*)(zb + so1 + 16 * kk + 8);
                acc0 = MFMA32(A, join8(l0, h0), acc0); acc1 = MFMA32(A, join8(l1, h1), acc1); } }
#pragma unroll
        for (int nb = 0; nb < 2; ++nb)
#pragma unroll
            for (int g = 0; g < 4; ++g) { const int t = 32 * r + 8 * g + 4 * h;
                const f32x4 gt = conv4(grow + nb * 1024, t, 1024, gw0, gw1, gw2);
                const int zo = nb * ZB1 + r * ZSTR + 8 * g + 4 * h;
                const u32x2 zu = *(const u32x2*)(zb + zo);
                const f32x16& ac = nb ? acc1 : acc0;
                const float z0 = gt.x * (ac[4 * g + 0] + sk * bflo(zu.x)), z1 = gt.y * (ac[4 * g + 1] + sk * bfhi(zu.x)), z2 = gt.z * (ac[4 * g + 2] + sk * bflo(zu.y)), z3 = gt.w * (ac[4 * g + 3] + sk * bfhi(zu.y));
                u32x2 ov; ov.x = cvtpk(z0, z1); ov.y = cvtpk(z2, z3);
                if (o == 0) *(u32x2*)(zb + zo) = ov; else *(u32x2*)(YHT + (size_t)c * NTOK + NPT + nb * 1024 + t) = ov; }
        HY_WAVE_SYNC();
    }
}
__device__ __forceinline__ void hyena_item_mfma(CArgs& a, unsigned char* lds, int l, int item) {
    const int wave = __builtin_amdgcn_readfirstlane(opaque_tid() >> 6);
    unsigned char* wlds = lds + wave * 18432;
    __syncthreads();
    if (item < 32) hyena_sample_wave(a, wlds, l, item * 8 + wave);
    else hyena_prompt_wave(a, wlds, l, (item - 32) * 8 + wave);
}

__device__ __forceinline__ void mixer_phase(CArgs& a, unsigned char* lds, int l, int cidx) {
    unsigned* ctr = (unsigned*)(a.ws + WS_CTL) + 64 * cidx;
    volatile unsigned* slot = (volatile unsigned*)(lds + LDS_BYTES - 64);
    const int N_ITEMS = 16 + 32 + 256 + 32 + 80 + (l == 0 ? TR_DEFER_ITEMS : 0);
    for (;;) {
        __syncthreads();
        if (threadIdx.x == 0) *slot = atomicAdd(ctr, 1u);
        __syncthreads();
        const int it = __builtin_amdgcn_readfirstlane((int)*slot);
        if (it >= N_ITEMS) break;
        int kind, sub;
        if (it < 16) { kind = 0; sub = it; } else if (it < 48) { kind = 1; sub = it - 16 + 32; } else if (it < 304) { kind = 0; sub = it - 48 + 16; } else if (it < 336) { kind = 1; sub = it - 304; } else if (it < 416) { kind = 2; sub = it - 336; } else { kind = 3; sub = it - 416; }
#ifdef RK
        if (cidx >= 3) { const int cls = it < 16 ? 1 : it < 48 ? 8 : it < 304 ? 4 : it < 336 ? 2 : it < 416 ? 16 : 32; if (!((RK) & cls)) continue; }
#endif
        const __attribute__((address_space(4))) Args* ap2 = &a; asm volatile("" : "+s"(ap2)); CArgs& a2 = *ap2;
#ifdef DBGVAR
        if (kind == 0) { if (cidx >= 3) mlstm_item_mfma<DBGVAR>(a2, lds, l, sub); else mlstm_item_mfma<0>(a2, lds, l, sub); }
#else
        if (kind == 0) mlstm_item_mfma<0>(a2, lds, l, sub);
#endif
        else if (kind == 1) hyena_item_mfma(a2, lds, l, sub);
        else if (kind == 2) { for (int q = 0; q < 8; ++q) sc_item(a2, l, sub * 8 + q); }
        else if (l == 0) { const int q = trq_fetch(a2, lds); if (q < TR_DEFER_ITEMS) transpose_block_item(a2, lds, q); }
    }
}

__device__ __forceinline__ void combine_rows(CArgs& a, unsigned char* lds, int l, int tix0, int tixs, int tixe, int row0, int rows, int rowe) {
    const int tid = threadIdx.x, lane = tid & 63;
    {
        const bf16* YHT = (const bf16*)(a.ws + WS_YHT); bf16* Yo = (bf16*)(a.ws + WS_Y); bf16* tile = (bf16*)lds;
        for (int tix = tix0; tix < tixe; tix += tixs) { const int c0 = (tix & 3) * 64, t0 = (tix >> 2) * 64;
            __syncthreads();
            { const int ch = tid >> 3, pc = tid & 7; *(u32x4*)(tile + ch * 72 + 8 * pc) = *(const u32x4*)(YHT + (size_t)(c0 + ch) * NTOK + t0 + 8 * pc); }
            __syncthreads();
            { const int tk = tid >> 3, pc = tid & 7; unsigned short e[8];
#pragma unroll
              for (int q = 0; q < 8; ++q) e[q] = tile[(8 * pc + q) * 72 + tk];
              u32x4 o; o.x = e[0] | ((unsigned)e[1] << 16); o.y = e[2] | ((unsigned)e[3] << 16); o.z = e[4] | ((unsigned)e[5] << 16); o.w = e[6] | ((unsigned)e[7] << 16);
              *(u32x4*)(Yo + (size_t)(t0 + tk) * D + 256 + c0 + 8 * pc) = o; } }
    }
    const bf16* HF = (const bf16*)(a.ws + WS_HF); const bf16* HB = (const bf16*)(a.ws + WS_HB); const bf16* P = (const bf16*)(a.ws + WS_PROJ); bf16* Y = (bf16*)(a.ws + WS_Y);
    const float* ng = a.in[I_MLNG] + l * 512;
    constexpr int RB = 4; const int stride = rows;
    for (int r0 = row0; r0 < rowe; r0 += stride * RB) {
        u32x4 rf[RB], rb[RB], ro[RB];
#pragma unroll
        for (int k = 0; k < RB; ++k) { int r = r0 + k * stride; r = r < rowe ? r : rowe - 1;
            rf[k] = ld8(HF + (size_t)r * 512 + 8 * lane); rb[k] = ld8(HB + (size_t)r * 512 + 8 * lane); ro[k] = ld8(P + (size_t)r * PLD + ML_OFF + 1536 + 8 * lane); }
#pragma unroll
        for (int k = 0; k < RB; ++k) { const int r = r0 + k * stride; if (r < rowe) {
            float hf[8], hb[8], ov[8], h[8];
            unpack8(rf[k], hf); unpack8(rb[k], hb); unpack8(ro[k], ov);
            float ss = 0.f;
#pragma unroll
            for (int e = 0; e < 8; ++e) { h[e] = hf[e] + hb[e]; ss += h[e] * h[e]; }
            ss = DPP_ADD(ss, 0xB1); ss = DPP_ADD(ss, 0x4E); ss = DPP_ADD(ss, 0x141); ss = DPP_ADD(ss, 0x140);
            const float rstd = 1.0f / sqrtf(ss * (1.0f / 128.0f) + EPS);
#pragma unroll
            for (int e = 0; e < 8; ++e) h[e] = h[e] * rstd * ng[8 * lane + e] * sigmoid_f(ov[e]);
            u32x4 o; o.x = cvtpk(h[0], h[1]); o.y = cvtpk(h[2], h[3]); o.z = cvtpk(h[4], h[5]); o.w = cvtpk(h[6], h[7]);
            *(u32x4*)(Y + (size_t)r * D + 512 + 8 * lane) = o; } }
    }
}

#define XB_TMO      128
#define XB_XCNT(j)  (256  + 64 * (j))
#define XB_XSUB(j)  (1280 + 64 * (j))
#define XB_XGEN(j)  (2304 + 64 * (j))
#define XB_TOP      3328
#define XB_TOPGEN   3392
#define XCD_BAR_WORDS 3456
#define XB_SPIN_CAP (1u << 18)

__device__ __forceinline__ unsigned xb_ld(unsigned* p)              { return __hip_atomic_load(p, __ATOMIC_RELAXED, __HIP_MEMORY_SCOPE_AGENT); }
__device__ __forceinline__ unsigned xb_add(unsigned* p, unsigned v) { return __hip_atomic_fetch_add(p, v, __ATOMIC_RELAXED, __HIP_MEMORY_SCOPE_AGENT); }
__device__ __forceinline__ unsigned xb_xcc_id() { return (unsigned)__builtin_amdgcn_s_getreg((3 << 11) | 20) & 0xFu; }
#define XB_SPIN(cond, bar) do { unsigned _sp = 0; while (cond) { __builtin_amdgcn_s_sleep(1); \
    if ((++_sp & 255u) == 0u) { if (xb_ld(&(bar)[XB_TMO])) break; if (_sp > XB_SPIN_CAP) { atomicAdd(&(bar)[XB_TMO], 1u); break; } } } } while (0)

struct XcdBarrier {
    unsigned* bar; unsigned x;
    volatile LAS unsigned* st;
};

__device__ __forceinline__ XcdBarrier xcd_barrier_post(unsigned* bar, volatile LAS unsigned* st) {
    XcdBarrier b; b.bar = bar; b.x = xb_xcc_id(); b.st = st;
    if (threadIdx.x == 0) (void)xb_add(&bar[XB_XCNT(b.x)], 1u);
    return b;
}
__device__ __forceinline__ void xcd_barrier_complete(unsigned* bar, unsigned x, unsigned& nloc, unsigned& nx) {
    const unsigned G = gridDim.x * gridDim.y * gridDim.z;
    unsigned sum, cnt, mine, sp = 0u;
    for (;;) {
        sum = 0u; cnt = 0u; mine = 0u;
#pragma unroll
        for (unsigned j = 0; j < 16; ++j) { const unsigned c = xb_ld(&bar[XB_XCNT(j)]); sum += c; cnt += (c > 0u) ? 1u : 0u; mine = (j == x) ? c : mine; }
        if (sum == G) break;
        __builtin_amdgcn_s_sleep(1);
        if ((++sp & 255u) == 0u) { if (xb_ld(&bar[XB_TMO])) break; if (sp > XB_SPIN_CAP) { atomicAdd(&bar[XB_TMO], 1u); break; } }
    }
    nloc = mine > 0u ? mine : 1u; nx = cnt > 0u ? cnt : 1u;
}

__device__ __forceinline__ void xcd_barrier(const XcdBarrier& b) {
    asm volatile("s_waitcnt vmcnt(0)" ::: "memory");
    __syncthreads();
    if (threadIdx.x == 0) {
        unsigned* bar = b.bar;
        __builtin_amdgcn_s_waitcnt(0);
        unsigned nloc = b.st[0], nx = b.st[1];
        if (nloc == 0u) { xcd_barrier_complete(bar, b.x, nloc, nx); b.st[0] = nloc; b.st[1] = nx; }
        const unsigned old = xb_add(&bar[XB_XSUB(b.x)], 1u);
        const unsigned gen = old / nloc;
        if (old + 1u == (gen + 1u) * nloc) {
            __builtin_amdgcn_fence(__ATOMIC_RELEASE, "agent");
            asm volatile("s_waitcnt vmcnt(0)" ::: "memory");
            const unsigned og = xb_add(&bar[XB_TOP], 1u);
            const unsigned tg = og / nx;
            if (og + 1u == (tg + 1u) * nx) xb_add(&bar[XB_TOPGEN], 1u);
            else XB_SPIN(xb_ld(&bar[XB_TOPGEN]) == tg, bar);
            __builtin_amdgcn_fence(__ATOMIC_ACQUIRE, "agent");
            xb_add(&bar[XB_XGEN(b.x)], 1u);
            asm volatile("s_waitcnt vmcnt(0)" ::: "memory");
        } else {
            XB_SPIN(xb_ld(&bar[XB_XGEN(b.x)]) == gen, bar);
            __builtin_amdgcn_fence(__ATOMIC_ACQUIRE, "agent");
            asm volatile("s_waitcnt vmcnt(0)" ::: "memory");
        }
    }
    __syncthreads();
}

__device__ __forceinline__ XcdBarrier xcd_barrier_make() {
    const __attribute__((address_space(4))) Args* ap_ = (const __attribute__((address_space(4))) Args*)__builtin_amdgcn_kernarg_segment_ptr(); asm volatile("" : "+s"(ap_));
    extern __shared__ __attribute__((aligned(16))) unsigned char lds_[];
    XcdBarrier b; b.bar = (unsigned*)(ap_->ws + WS_CTL) + 4096; b.x = xb_xcc_id(); b.st = (volatile LAS unsigned*)((LAS unsigned char*)lds_ + LDS_BYTES - 32); return b;
}
constexpr int N_PHASES = 11;
#ifndef REPEAT_PH
#define REPEAT_PH (-1)
#endif
constexpr size_t CTL_PANEL = 32768;
#define LAYER_PHASES(l, pb) do { \
        if (IN(pb)) { \
            PHASE_ARGS(); unsigned char* ws = a.ws; \
            const bf16* wt = (const bf16*)(ws + WS_WIN) + (size_t)l * NPROJ * 1024; \
            { pg8::Gemm g{(const bf16*)(ws + WS_U), wt, NTOK, PLD, 1024}; pg8::StaticOrder S; S.init(NTOK, PLD, G, (int)blockIdx.x); \
              EpiBf16<0> E{(bf16*)(ws + WS_PROJ), PLD}; \
              pg8::gemm_phase<EpiBf16<0>, pg8::StaticOrder, true, true>((PG8_LAS unsigned char*)lds, g, S, E); } \
            { pg8::Gemm g{wt + (size_t)PLD * 1024, (const bf16*)(ws + WS_U), 768, NTOK, 1024}; pg8::StaticOrder S; S.init(768, NTOK, G, (int)blockIdx.x); \
              EpiBf16<0> E{(bf16*)(ws + WS_HYT), NTOK}; \
              pg8::gemm_phase<EpiBf16<0>, pg8::StaticOrder, true, true>((PG8_LAS unsigned char*)lds, g, S, E); } \
            if (l == 1) { norm_wg_load(a, lds, 1); for (;;) { volatile unsigned* sl_ = (volatile unsigned*)(lds + LDS_BYTES - 320); __syncthreads(); if (threadIdx.x == 0) *sl_ = atomicAdd((unsigned*)(ws + WS_CTL) + 64 * 15, 1u); __syncthreads(); \
                    const int q_ = __builtin_amdgcn_readfirstlane((int)*sl_); if (q_ >= 256) break; gates_block_item(a, lds, 1, q_); } }     \
            if (l == 0) { const int b_ = (int)blockIdx.x; const int nu = (b_ < 440 - 256 ? 2 : 1) + (b_ < 120 ? 1 : 0); \
                for (int q_ = 0; q_ < (3 - nu) * TR_QUOTA; ++q_) { const int it_ = trq_fetch(a, lds); if (it_ >= TR_DEFER_ITEMS) break; transpose_block_item(a, lds, it_); } } \
        } SEAM(pb); \
        if (IN(pb + 1)) { PHASE_ARGS(); mixer_phase(a, lds, l, 1 + l); if (REPEAT_PH == pb + 1) { xcd_barrier(XBAR_NOW()); mixer_phase(a, lds, l, 3 + l); } } SEAM(pb + 1); \
        if (IN(pb + 2)) { \
            PHASE_ARGS(); unsigned char* ws = a.ws; const float* mod = (const float*)(ws + WS_MOD) + (size_t)l * 3 * 6144; \
            pg8::Gemm g{(const bf16*)(ws + WS_Y), (const bf16*)(ws + WS_WOUT) + (size_t)l * 1024 * 1024, NTOK, 1024, 1024}; pg8::StaticOrder S; S.init(NTOK, 1024, G, (int)blockIdx.x); \
            { pg8::Unit u0; if (first_unit(NTOK / 256, 4, (int)blockIdx.x, u0)) {     \
                const int tok0 = u0.pm * 256 + u0.pn * 64; \
                combine_rows(a, lds, l, (tok0 >> 6) * 4, 1, (tok0 >> 6) * 4 + 4, tok0 + (int)(threadIdx.x >> 6), 8, tok0 + 64); \
                asm volatile("s_waitcnt vmcnt(0)" ::: "memory"); __syncthreads(); \
                if (threadIdx.x == 0) { unsigned* c_ = (unsigned*)(ws + WS_CTL) + CTL_PANEL + (4 + l) * 4096 + 64 * u0.pm; \
                    __builtin_amdgcn_fence(__ATOMIC_RELEASE, "agent"); asm volatile("s_waitcnt vmcnt(0)" ::: "memory"); \
                    (void)__hip_atomic_fetch_add(c_, 1u, __ATOMIC_RELAXED, __HIP_MEMORY_SCOPE_AGENT); unsigned sp_ = 0; \
                    while (__hip_atomic_load(c_, __ATOMIC_RELAXED, __HIP_MEMORY_SCOPE_AGENT) < 4u && ++sp_ < (1u << 22)) __builtin_amdgcn_s_sleep(1); \
                    __builtin_amdgcn_fence(__ATOMIC_ACQUIRE, "agent"); asm volatile("s_waitcnt vmcnt(0)" ::: "memory"); } \
                __syncthreads(); } } \
            EpiResid E{a.ph_hi >= 1000 ? (float*)(ws + WS_PROJ) : a.out, mod + 2048}; \
            pg8::gemm_phase<EpiResid, pg8::StaticOrder, true, true>((PG8_LAS unsigned char*)lds, g, S, E); \
            panel_tail<false, false>(a, lds, l, 2, (unsigned*)(ws + WS_CTL) + CTL_PANEL + (2 * l) * 4096, S); \
        } SEAM(pb + 2); \
        if (IN(pb + 3)) { \
            PHASE_ARGS(); unsigned char* ws = a.ws; \
            pg8::Gemm g{(const bf16*)(ws + WS_U), (const bf16*)(ws + WS_W1) + (size_t)l * DFF * 1024, NTOK, DFF, 1024}; pg8::StaticOrder S; S.init(NTOK, DFF, G, (int)blockIdx.x); \
            EpiBf16<1> E{(bf16*)(ws + WS_PROJ), DFF}; \
            pg8::gemm_phase<EpiBf16<1>, pg8::StaticOrder, true, true>((PG8_LAS unsigned char*)lds, g, S, E); \
            if (REPEAT_PH == 100 + pb + 3) { xcd_barrier(XBAR_NOW()); pg8::gemm_phase<EpiBf16<1>, pg8::StaticOrder, true, true>((PG8_LAS unsigned char*)lds, g, S, E); } \
            if (REPEAT_PH == 200 + pb + 3) { for (int q_ = 0; q_ < 10; ++q_) xcd_barrier(XBAR_NOW()); } \
        } SEAM(pb + 3); \
        if (IN(pb + 4)) { \
            PHASE_ARGS(); unsigned char* ws = a.ws; const float* mod = (const float*)(ws + WS_MOD) + (size_t)l * 3 * 6144; \
            pg8::Gemm g{(const bf16*)(ws + WS_PROJ), (const bf16*)(ws + WS_W2) + (size_t)l * 1024 * DFF, NTOK, 1024, DFF}; pg8::StaticOrder S; S.init(NTOK, 1024, G, (int)blockIdx.x); \
            if (l == 0 && (int)blockIdx.x >= 160) {     \
                for (;;) { volatile unsigned* sl_ = (volatile unsigned*)(lds + LDS_BYTES - 320); __syncthreads(); if (threadIdx.x == 0) *sl_ = atomicAdd((unsigned*)(ws + WS_CTL) + 64 * 13, 1u); __syncthreads(); \
                    const int q_ = __builtin_amdgcn_readfirstlane((int)*sl_); if (q_ >= TR_L1_ITEMS + 80) break; \
                    if (q_ < TR_L1_ITEMS) transpose_block_item(a, lds, q_, TR_PER, 2 * TR_PER); else filter_block_item(a, lds, 80 + q_ - TR_L1_ITEMS); } } \
            EpiResid E{a.ph_hi >= 1000 ? (float*)(ws + WS_U) : a.out, mod + 5120}; \
            pg8::gemm_phase<EpiResid, pg8::StaticOrder, true, true>((PG8_LAS unsigned char*)lds, g, S, E); \
            if (REPEAT_PH == 300 + pb + 4) { xcd_barrier(XBAR_NOW()); EpiBf16<0> E2{(bf16*)(ws + WS_Y), 1024}; pg8::gemm_phase<EpiBf16<0>, pg8::StaticOrder, true, true>((PG8_LAS unsigned char*)lds, g, S, E2); } \
            if (l == 0) panel_tail<false, false>(a, lds, 1, 1, (unsigned*)(ws + WS_CTL) + CTL_PANEL + 1 * 4096, S);     \
            else panel_tail<false, true>(a, lds, 0, 0, (unsigned*)(ws + WS_CTL) + CTL_PANEL + 3 * 4096, S); \
        } if ((pb) + 4 < N_PHASES - 1) SEAM(pb + 4); \
    } while (0)

__global__ void __launch_bounds__(512, 2) mk_fwd(Args a_) {
    extern __shared__ __attribute__((aligned(16))) unsigned char lds[];
    cg::grid_group grid = cg::this_grid();
    volatile LAS unsigned* bst = (volatile LAS unsigned*)((LAS unsigned char*)lds + LDS_BYTES - 32);
    if (threadIdx.x < 2) bst[threadIdx.x] = 0u;
    __syncthreads();
    (void)xcd_barrier_post((unsigned*)(a_.ws + WS_CTL) + 4096, bst);
#define XBAR_NOW() xcd_barrier_make()
    const int lo = a_.ph_lo, hi = a_.ph_hi >= 1000 ? a_.ph_hi - 1000 : a_.ph_hi;
    const int G = gridDim.x;
#define IN(k) (lo <= (k) && (k) < hi)
#define SEAM(k) do { if (IN(k) && IN((k) + 1)) { if ((k) == 0) grid.sync(); else xcd_barrier(XBAR_NOW()); } } while (0)
    if (IN(0)) { PHASE_ARGS(); p0_prologue(a, lds);
        unsigned* ctl = (unsigned*)(a.ws + WS_CTL);
        __syncthreads();
        if (threadIdx.x == 0) { unsigned sp_ = 0; while (__hip_atomic_load(ctl + 64 * 11, __ATOMIC_RELAXED, __HIP_MEMORY_SCOPE_AGENT) < 192u && ++sp_ < (1u << 22)) __builtin_amdgcn_s_sleep(1);
            __builtin_amdgcn_fence(__ATOMIC_ACQUIRE, "agent"); asm volatile("s_waitcnt vmcnt(0)" ::: "memory"); }
        __syncthreads();
        volatile unsigned* nslot = (volatile unsigned*)(lds + LDS_BYTES - 256);
        norm_wg_load(a, lds, 0);
        for (;;) {
            __syncthreads();
            if (threadIdx.x == 0) *nslot = atomicAdd(ctl + 64 * 12, 1u);
            __syncthreads();
            const int it = __builtin_amdgcn_readfirstlane((int)*nslot);
            if (it >= 256 || (PV == 2 && a.ph_hi >= 1000)) break;
            const __attribute__((address_space(4))) Args* ap2 = &a; asm volatile("" : "+s"(ap2)); CArgs& a2 = *ap2;
            norm_rows<0, true, false>(a2, lds, 0, 1, 40 * it + (opaque_tid() >> 6), 8, 40 * it + 40, false);
        }
    } SEAM(0);
    LAYER_PHASES(0, 1);
    LAYER_PHASES(1, 6);
#undef IN
#undef SEAM
}

#ifdef DBG_STOP
__global__ void dbg_dump(const unsigned short* buf, size_t n16, float* out, int mode) {
    const size_t cap = mode == 2 ? 8388608 : 10485760, base = mode == 2 ? OUT_C : 0;
    const size_t n = n16 / DBG_E < cap ? n16 / DBG_E : cap;
    for (size_t i = (size_t)blockIdx.x * blockDim.x + threadIdx.x; i < cap; i += (size_t)gridDim.x * blockDim.x) {
        float v = 1.f;
        if (i < n) { v = 0.f; for (int e = 0; e < DBG_E; ++e) v += bflo(buf[DBG_E * i + e]); }
        out[base + i] = v;
    }
}
#endif

#ifdef DBG2_K
__global__ void dbg2_cmp(const unsigned* a, const unsigned* b, size_t nwords, int isf32, unsigned* res) {
    unsigned cnt = 0; float mx = 0.f;
    for (size_t i = (size_t)blockIdx.x * blockDim.x + threadIdx.x; i < nwords; i += (size_t)gridDim.x * blockDim.x) {
        const unsigned x = a[i], y = b[i];
        if (x != y) { ++cnt; float d;
            if (isf32) d = fabsf(__builtin_bit_cast(float, x) - __builtin_bit_cast(float, y));
            else d = fmaxf(fabsf(bflo(x & 0xffffu) - bflo(y & 0xffffu)), fabsf(bfhi(x) - bfhi(y)));
            if (!(d == d)) d = 1e30f; mx = fmaxf(mx, d); } }
    if (cnt) { atomicAdd(res, cnt); atomicMax(res + 1, __builtin_bit_cast(unsigned, mx)); }
}
__global__ void dbg2_fill(const unsigned* res, float* out, size_t n) {
    const unsigned cnt = res[0]; const float mx = __builtin_bit_cast(float, res[1]);
    float V;
    if (cnt == 0) V = 5e35f;
    else { const float mant = 1.0f + log10f((float)cnt); int e = (int)floorf(log10f(fmaxf(mx, 1e-12f))); if (e < -12) e = -12; if (e > 12) e = 12; V = mant * powf(10.f, (float)(20 + e)); }
    for (size_t i = (size_t)blockIdx.x * blockDim.x + threadIdx.x; i < n; i += (size_t)gridDim.x * blockDim.x) out[i] = V;
}
#endif
extern "C" void kernel_launch(void* const* d_in, const int* in_sizes, int n_in, void* d_out, int out_size, void* d_ws, size_t ws_size, hipStream_t stream) {
    static int grid = 0;
    if (grid == 0) {
        if (n_in != 28 || ws_size < WS_END) { fprintf(stderr, "kernel_launch: unexpected n_in %d / ws_size %zu\n", n_in, ws_size); grid = -1; return; }
        int dev = 0, cus = 0, per_cu = 0;
        (void)hipGetDevice(&dev); (void)hipDeviceGetAttribute(&cus, hipDeviceAttributeMultiprocessorCount, dev);
        if (hipFuncSetAttribute((const void*)mk_fwd, hipFuncAttributeMaxDynamicSharedMemorySize, LDS_BYTES) != hipSuccess) { fprintf(stderr, "kernel_launch: hipFuncSetAttribute failed\n"); grid = -1; return; }
        if (hipOccupancyMaxActiveBlocksPerMultiprocessor(&per_cu, (const void*)mk_fwd, 512, LDS_BYTES) != hipSuccess || per_cu < 1) { fprintf(stderr, "kernel_launch: occupancy query says %d\n", per_cu); per_cu = 1; }
        (void)hipGetLastError();
        grid = cus * 1;
        fprintf(stderr, "kernel_launch: cus %d per_cu %d grid %d ws %zu\n", cus, per_cu, grid, ws_size);
    }
    if (grid < 0) return;
    (void)hipMemsetAsync((char*)d_ws + WS_CTL, 0, CTL_BYTES, stream);
    Args a{};
    for (int i = 0; i < 28; ++i) a.in[i] = (const float*)d_in[i];
    a.out = (float*)d_out; a.ws = (unsigned char*)d_ws;
#if MK_ONE_LAUNCH
    a.ph_lo = 0; a.ph_hi = N_PHASES;
    void* args[] = {&a};
    hipError_t e = hipLaunchCooperativeKernel((const void*)mk_fwd, dim3(grid), dim3(512), args, LDS_BYTES, stream);
    if (e != hipSuccess) fprintf(stderr, "kernel_launch: cooperative launch failed: %s\n", hipGetErrorString(e));
#ifdef PROBE_PHASE
    { Args b = a; b.ph_lo = PROBE_PHASE; b.ph_hi = 1000 + PROBE_PHASE + 1; void* args2[] = {&b};
      (void)hipMemsetAsync((char*)d_ws + WS_CTL, 0, CTL_BYTES, stream);
      (void)hipLaunchCooperativeKernel((const void*)mk_fwd, dim3(grid), dim3(512), args2, LDS_BYTES, stream); }
#endif
#else
#ifdef DBG2_K
    (void)hipMemsetAsync((char*)d_ws + (250u << 20), 0, 256, stream);
    for (int rep = 0; rep < 2; ++rep) {
        for (int p = 0; p < DBG2_K; ++p) { a.ph_lo = p; a.ph_hi = p + 1; hipLaunchKernelGGL(mk_fwd, dim3(grid), dim3(512), LDS_BYTES, stream, a); }
        if (rep == 0) (void)hipMemcpyAsync((char*)d_ws + (208u << 20), DBG2_SRC, (size_t)(DBG2_BYTES), hipMemcpyDeviceToDevice, stream);
    }
    hipLaunchKernelGGL(dbg2_cmp, dim3(1024), dim3(256), 0, stream, (const unsigned*)((const char*)d_ws + (208u << 20)), (const unsigned*)(DBG2_SRC), (size_t)(DBG2_BYTES) / 4, (int)(DBG2_F32), (unsigned*)((char*)d_ws + (250u << 20)));
    hipLaunchKernelGGL(dbg2_fill, dim3(1024), dim3(256), 0, stream, (const unsigned*)((const char*)d_ws + (250u << 20)), (float*)d_out, (size_t)out_size);
#elif defined(DBG_STOP)
    for (int p = 0; p < DBG_STOP; ++p) { a.ph_lo = p; a.ph_hi = p + 1; hipLaunchKernelGGL(mk_fwd, dim3(grid), dim3(512), LDS_BYTES, stream, a); }
    hipLaunchKernelGGL(dbg_dump, dim3(1024), dim3(256), 0, stream, (const unsigned short*)((const char*)d_ws + (size_t)(DBG_OFF)), (size_t)(DBG_BYTES) / 2, (float*)d_out, (int)(DBG_KEEP));
#else
    for (int p = 0; p < N_PHASES; ++p) { a.ph_lo = p; a.ph_hi = p + 1; hipLaunchKernelGGL(mk_fwd, dim3(grid), dim3(512), LDS_BYTES, stream, a); }
#endif
#endif
}
```

```cpp
#include <hip/hip_runtime.h>
#include <hip/hip_cooperative_groups.h>
#include <cstdio>
#include <cstdint>
namespace cg = cooperative_groups;
namespace pg8 {
#define PG8_LAS __attribute__((address_space(3)))
typedef unsigned short bf16_t;
typedef short bf16x8 __attribute__((ext_vector_type(8)));
typedef float f32x4 __attribute__((ext_vector_type(4)));
typedef unsigned u32x4 __attribute__((ext_vector_type(4)));
constexpr int BM = 256, BK = 64, HALF = 128, HTB = HALF * BK * 2  , STAGE_BYTES = 8 * HTB, NXCD = 8, WGM = 8;

__host__ __device__ __forceinline__ int lds_byte(int r, int c) { const int st = (r >> 4) * 2 + (c >> 5), rr = r & 15, cc = c & 31, ob = rr * 64 + cc * 2; return st * 1024 + (ob ^ (((ob >> 9) & 1) << 5)); }
__host__ __device__ __forceinline__ void stage_rc(int b, int& R, int& C) { const int st = b / 1024, sb = b % 1024, swz = sb ^ (((sb >> 9) & 1) << 5); R = (st >> 1) * 16 + swz / 64; C = (st & 1) * 32 + (swz % 64) / 2; }
__host__ __device__ __forceinline__ int perm32(int rho) { const int n = rho >> 4, i = rho & 15; return 8 * (i >> 2) + 4 * n + (i & 3); }

struct Unit { int pm, pn; };
struct Gemm { const bf16_t* A; const bf16_t* Bt; int M, N, K; };

struct StaticOrder {
    int nM, nN, nwg, G, c;
    __host__ __device__ void init(int M, int N, int G_, int c_) { nM = M / BM; nN = N / BM; nwg = nM * nN; G = G_; c = c_; }
    __host__ __device__ bool next(int i, Unit& u) const {
        const long L = (long)i * G + c; if (L >= nwg) return false;
        int wgid = (int)L; { const int q = nwg / NXCD, r = nwg % NXCD, xcd = wgid % NXCD, off = wgid / NXCD; wgid = (xcd < r ? xcd * (q + 1) : r * (q + 1) + (xcd - r) * q) + off; }
        const int nig = WGM * nN, gid = wgid / nig, fm = gid * WGM, gsz = (nM - fm) < WGM ? (nM - fm) : WGM;
        u.pm = fm + ((wgid % nig) % gsz); u.pn = (wgid % nig) / gsz; return true;
    }
    __device__ __forceinline__ void a_ready(const Unit&) const {}
    __device__ __forceinline__ void done(const Unit&) const {}
};

__device__ __forceinline__ unsigned cvt_pk_bf16(float lo, float hi) { unsigned r; asm volatile("v_cvt_pk_bf16_f32 %0, %1, %2" : "=v"(r) : "v"(lo), "v"(hi)); return r; }
typedef float f32x2 __attribute__((ext_vector_type(2)));

template <class Epi, class Sched, bool ALIGN_EPI = false, bool SP2 = false>
__device__ __forceinline__ void gemm_phase(PG8_LAS unsigned char* lds, const Gemm g, const Sched& S, const Epi& E) {
    const int tid = threadIdx.x, wid = __builtin_amdgcn_readfirstlane(tid >> 6), lane = tid & 63, wr = wid >> 2, wc = wid & 3, fr = lane & 15, fq = lane >> 4;
    const int K = g.K, nt = K / BK;
    unsigned voffA[2], voffB[2];
#pragma unroll
    for (int i = 0; i < 2; ++i) { int R, C; stage_rc(tid * 16 + i * 8192, R, C); const int Rb = Epi::PERM ? ((R & ~31) + perm32(R & 31)) : R;
        voffA[i] = (unsigned)(R * K + C) * 2u; voffB[i] = (unsigned)(Rb * K + C) * 2u; }
    const size_t kstep = (size_t)(BK * 2);
    const size_t hstep = (size_t)HALF * K * 2;
    const size_t tstep = 2 * hstep;
    const unsigned ldsw = (unsigned)wid * 1024u;
    const int aoff = lds_byte(wr * 64 + fr, fq * 8), boff = lds_byte(wc * 32 + fr, fq * 8);
#define PG8_SA(b, h) (((b) * 2 + (h)) * HTB)
#define PG8_SB(b, h) ((4 + (b) * 2 + (h)) * HTB)
#define PG8_STAGE(bufoff, gbase, voff) do { _Pragma("unroll") for (int _i = 0; _i < 2; ++_i) \
        __builtin_amdgcn_global_load_lds((const unsigned*)((const char*)(gbase) + (voff)[_i]), (PG8_LAS unsigned*)(lds + (bufoff) + ldsw + _i * 8192), 16, 0, 0); } while (0)
#define PG8_LDA(dst, b, h) do { _Pragma("unroll") for (int m = 0; m < 4; ++m) _Pragma("unroll") for (int k = 0; k < 2; ++k) dst[m][k] = *(const PG8_LAS bf16x8*)(lds + PG8_SA(b, h) + aoff + m * 2048 + k * 1024); } while (0)
#define PG8_LDB(dst, b, h) do { _Pragma("unroll") for (int n = 0; n < 2; ++n) _Pragma("unroll") for (int k = 0; k < 2; ++k) dst[n][k] = *(const PG8_LAS bf16x8*)(lds + PG8_SB(b, h) + boff + n * 2048 + k * 1024); } while (0)
#define PG8_MMA(ai, bj, At, Bt) do { __builtin_amdgcn_s_setprio(1); _Pragma("unroll") for (int m = 0; m < 4; ++m) _Pragma("unroll") for (int n = 0; n < 2; ++n) _Pragma("unroll") for (int k = 0; k < 2; ++k) \
        acc[ai][bj][m][n] = __builtin_amdgcn_mfma_f32_16x16x32_bf16(Bt[n][k], At[m][k], acc[ai][bj][m][n], 0, 0, 0); __builtin_amdgcn_s_setprio(0); } while (0)
#define PG8_WAIT_V(n) asm volatile("s_waitcnt vmcnt(" #n ")" ::: "memory")
#define PG8_WAIT_L(n) asm volatile("s_waitcnt lgkmcnt(" #n ")" ::: "memory")
#define PG8_BAR __builtin_amdgcn_s_barrier()
#define PG8_SCHED __builtin_amdgcn_sched_barrier(0)
    Unit cur, nxt; int ui = 0;
    if (!S.next(0, cur)) return;
    f32x4 acc[2][2][4][2];
#pragma unroll
    for (int a = 0; a < 2; ++a)
#pragma unroll
        for (int b = 0; b < 2; ++b)
#pragma unroll
            for (int m = 0; m < 4; ++m)
#pragma unroll
                for (int n = 0; n < 2; ++n) acc[a][b][m][n] = (f32x4){0.f, 0.f, 0.f, 0.f};
    bf16x8 At[4][2], B0[2][2], B1[2][2];
    const char* cA = (const char*)g.A + (size_t)cur.pm * tstep; const char* cB = (const char*)g.Bt + (size_t)cur.pn * tstep;
    S.a_ready(cur);
    if constexpr (SP2) {
        PG8_STAGE(PG8_SB(0, 0), cB, voffB); PG8_STAGE(PG8_SB(0, 1), cB + hstep, voffB); PG8_STAGE(PG8_SA(0, 0), cA, voffA); PG8_STAGE(PG8_SA(0, 1), cA + hstep, voffA);
        if (wr == 1) PG8_BAR;
        PG8_WAIT_V(2); PG8_BAR;
        PG8_STAGE(PG8_SB(1, 0), cB + kstep, voffB); PG8_STAGE(PG8_SA(1, 0), cA + kstep, voffA); PG8_STAGE(PG8_SB(1, 1), cB + hstep + kstep, voffB);
        PG8_WAIT_V(6); PG8_BAR;
    } else {
        PG8_STAGE(PG8_SB(0, 0), cB, voffB); PG8_STAGE(PG8_SA(0, 0), cA, voffA); PG8_STAGE(PG8_SB(0, 1), cB + hstep, voffB); PG8_STAGE(PG8_SA(0, 1), cA + hstep, voffA);
        if (wr == 1) PG8_BAR;
        PG8_WAIT_V(4); PG8_BAR;
        PG8_STAGE(PG8_SB(1, 0), cB + kstep, voffB); PG8_STAGE(PG8_SA(1, 0), cA + kstep, voffA); PG8_STAGE(PG8_SB(1, 1), cB + hstep + kstep, voffB);
        PG8_WAIT_V(6); PG8_BAR;
    }
    for (;;) {
        const bool has_next = S.next(ui + 1, nxt);
        const char* nA = has_next ? (const char*)g.A + (size_t)nxt.pm * tstep : cA; const char* nB = has_next ? (const char*)g.Bt + (size_t)nxt.pn * tstep : cB;
        for (int t = 0; t < nt; t += 2) {
            const bool last = (t == nt - 2);
            const char* a1 = cA + (size_t)(t + 1) * kstep;
            const char* a2 = last ? nA : cA + (size_t)(t + 2) * kstep; const char* b2 = last ? nB : cB + (size_t)(t + 2) * kstep;
            const char* a3 = a2 + kstep; const char* b3 = b2 + kstep;
            if (last && has_next) S.a_ready(nxt);
            if constexpr (SP2) {
            PG8_LDB(B0, 0, 0); PG8_LDB(B1, 0, 1); PG8_SCHED; PG8_LDA(At, 0, 0); PG8_STAGE(PG8_SA(1, 1), a1 + hstep, voffA);
            PG8_WAIT_V(8); PG8_WAIT_L(0); PG8_BAR; PG8_MMA(0, 0, At, B0); PG8_MMA(0, 1, At, B1); PG8_BAR; PG8_SCHED;
            PG8_LDA(At, 0, 1); PG8_STAGE(PG8_SB(0, 0), b2, voffB); PG8_STAGE(PG8_SB(0, 1), b2 + hstep, voffB); PG8_STAGE(PG8_SA(0, 0), a2, voffA);
            PG8_WAIT_V(8); PG8_WAIT_L(0); PG8_BAR; PG8_MMA(1, 0, At, B0); PG8_MMA(1, 1, At, B1); PG8_BAR; PG8_SCHED;
            PG8_LDB(B0, 1, 0); PG8_LDB(B1, 1, 1); PG8_SCHED; PG8_LDA(At, 1, 0); PG8_STAGE(PG8_SA(0, 1), a2 + hstep, voffA);
            PG8_WAIT_V(8); PG8_WAIT_L(0); PG8_BAR; PG8_MMA(0, 0, At, B0); PG8_MMA(0, 1, At, B1); PG8_BAR; PG8_SCHED;
            PG8_LDA(At, 1, 1); PG8_STAGE(PG8_SB(1, 0), b3, voffB); PG8_STAGE(PG8_SB(1, 1), b3 + hstep, voffB); PG8_STAGE(PG8_SA(1, 0), a3, voffA);
            PG8_WAIT_V(8); PG8_WAIT_L(0); PG8_BAR; PG8_MMA(1, 0, At, B0); PG8_MMA(1, 1, At, B1); PG8_BAR; PG8_SCHED;
            } else {
            PG8_LDB(B0, 0, 0); PG8_SCHED; PG8_LDA(At, 0, 0); PG8_STAGE(PG8_SA(1, 1), a1 + hstep, voffA);
            PG8_WAIT_L(8); PG8_BAR; PG8_WAIT_L(0); PG8_MMA(0, 0, At, B0); PG8_BAR; PG8_SCHED;
            PG8_LDB(B1, 0, 1); PG8_STAGE(PG8_SB(0, 0), b2, voffB);
            PG8_BAR; PG8_WAIT_L(0); PG8_MMA(0, 1, At, B1); PG8_BAR;
            PG8_LDA(At, 0, 1); PG8_STAGE(PG8_SA(0, 0), a2, voffA);
            PG8_BAR; PG8_WAIT_L(0); PG8_MMA(1, 0, At, B0); PG8_BAR; PG8_SCHED;
            PG8_STAGE(PG8_SB(0, 1), b2 + hstep, voffB);
            PG8_WAIT_V(6); PG8_BAR; PG8_MMA(1, 1, At, B1); PG8_BAR;
            PG8_LDB(B0, 1, 0); PG8_SCHED; PG8_LDA(At, 1, 0); PG8_STAGE(PG8_SA(0, 1), a2 + hstep, voffA);
            PG8_WAIT_L(8); PG8_BAR; PG8_WAIT_L(0); PG8_MMA(0, 0, At, B0); PG8_BAR; PG8_SCHED;
            PG8_LDB(B1, 1, 1); PG8_STAGE(PG8_SB(1, 0), b3, voffB);
            PG8_BAR; PG8_WAIT_L(0); PG8_MMA(0, 1, At, B1); PG8_BAR;
            PG8_LDA(At, 1, 1); PG8_STAGE(PG8_SA(1, 0), a3, voffA);
            PG8_BAR; PG8_WAIT_L(0); PG8_MMA(1, 0, At, B0); PG8_BAR; PG8_SCHED;
            PG8_STAGE(PG8_SB(1, 1), b3 + hstep, voffB);
            PG8_WAIT_V(6); PG8_BAR; PG8_MMA(1, 1, At, B1); PG8_BAR;
            }
        }
        if constexpr (ALIGN_EPI) { if (wr == 0) PG8_BAR; }
        if constexpr (!Epi::AFTER_DRAIN) { E(acc, cur, wr, wc, fr, fq); S.done(cur); }
        if (!has_next) break;
#pragma unroll
        for (int a = 0; a < 2; ++a)
#pragma unroll
            for (int b = 0; b < 2; ++b)
#pragma unroll
                for (int m = 0; m < 4; ++m)
#pragma unroll
                    for (int n = 0; n < 2; ++n) acc[a][b][m][n] = (f32x4){0.f, 0.f, 0.f, 0.f};
        cur = nxt; cA = nA; cB = nB; ++ui;
        if constexpr (ALIGN_EPI) { if (wr == 1) PG8_BAR; }
    }
    PG8_WAIT_V(0);
    if constexpr (!ALIGN_EPI) { if (wr == 0) PG8_BAR; }
    PG8_BAR;
    if constexpr (Epi::AFTER_DRAIN) { E.fused(acc, cur, wr, wc, fr, fq, lds, wid, lane); S.done(cur); }
#undef PG8_SA
#undef PG8_SB
#undef PG8_STAGE
#undef PG8_LDA
#undef PG8_LDB
#undef PG8_MMA
#undef PG8_WAIT_V
#undef PG8_WAIT_L
#undef PG8_BAR
#undef PG8_SCHED
}
}

#ifndef MK_ONE_LAUNCH
#define MK_ONE_LAUNCH 1
#endif
#define LAS __attribute__((address_space(3)))
typedef unsigned short bf16;
typedef float f32x4 __attribute__((ext_vector_type(4)));
typedef unsigned u32x4 __attribute__((ext_vector_type(4)));
typedef unsigned u32x2 __attribute__((ext_vector_type(2)));

constexpr int D = 1024, NTOK = 10240, NPT = 8192, LP = 256, LS = 1024, NSEQ = 34;
constexpr int NPROJ = 3584, NIN = 3600, DFF = 4096, PLD = 2816;
constexpr int SC_OFF = 0, ML_OFF = 768;
constexpr float EPS = 1e-6f;
constexpr size_t MiB = 1u << 20;
constexpr size_t WS_CTL = 0, CTL_BYTES = 262144;
constexpr size_t WS_WIN = 1 * MiB, WS_WOUT = 15 * MiB, WS_W1 = 19 * MiB, WS_W2 = 35 * MiB, WS_MOD = 51 * MiB, WS_FILT = 52 * MiB, WS_GATES = 62 * MiB;
constexpr size_t WS_U = 63 * MiB, WS_Y = 83 * MiB, WS_HF = 103 * MiB, WS_HB = 113 * MiB, WS_PROJ = 123 * MiB, WS_HYT = 203 * MiB, WS_YHT = 218 * MiB, WS_END = 223 * MiB;
constexpr int LDS_BYTES = 155648;
constexpr size_t OUT_YS = 8388608, OUT_C = 10485760, OUT_N = 18874368, OUT_M = 18939904;
constexpr size_t FILT_L = 5 * MiB / 4;

struct Args { const float* in[28]; float* out; unsigned char* ws; int ph_lo, ph_hi; };
typedef const __attribute__((address_space(4))) Args CArgs;
#define PHASE_ARGS() const __attribute__((address_space(4))) Args* ap_ = (const __attribute__((address_space(4))) Args*)__builtin_amdgcn_kernarg_segment_ptr(); asm volatile("" : "+s"(ap_)); CArgs& a = *ap_
enum { I_XP = 0, I_XS, I_SC, I_SN, I_SM, I_C, I_CCTX, I_N1G, I_ADAW, I_ADAB, I_WIN, I_SCW, I_HYCW, I_HW1, I_HB1, I_HW2, I_HB2, I_HW3, I_HFREQ, I_HSKIP, I_MLCW, I_MLGB, I_MLNG, I_WOUT, I_N2G, I_W1, I_W2, I_NFG };

typedef float f32x2_t __attribute__((ext_vector_type(2))); typedef __bf16 bf16x2_t __attribute__((ext_vector_type(2)));
__device__ __forceinline__ unsigned cvtpk(float lo, float hi) { f32x2_t v = {lo, hi}; bf16x2_t b = __builtin_convertvector(v, bf16x2_t); return __builtin_bit_cast(unsigned, b); }
__device__ __forceinline__ unsigned f2bf(float f) { unsigned u = __builtin_bit_cast(unsigned, f); return (u + 0x7fffu + ((u >> 16) & 1u)) >> 16; }
__device__ __forceinline__ unsigned pk2(float lo, float hi) { return f2bf(lo) | (f2bf(hi) << 16); }
__device__ __forceinline__ float bflo(unsigned u) { return __builtin_bit_cast(float, u << 16); }
__device__ __forceinline__ float bfhi(unsigned u) { return __builtin_bit_cast(float, u & 0xffff0000u); }
__device__ __forceinline__ void unpack8(const u32x4 v, float* f) { f[0] = bflo(v.x); f[1] = bfhi(v.x); f[2] = bflo(v.y); f[3] = bfhi(v.y); f[4] = bflo(v.z); f[5] = bfhi(v.z); f[6] = bflo(v.w); f[7] = bfhi(v.w); }
__device__ __forceinline__ u32x4 ld8(const bf16* p) { return *(const u32x4*)p; }
#define DPP_ADD(v, CTRL) ((v) + __builtin_bit_cast(float, __builtin_amdgcn_update_dpp(0, __builtin_bit_cast(int, (v)), (CTRL), 0xf, 0xf, true)))
__device__ __forceinline__ float wave_sum(float v) {
    v = DPP_ADD(v, 0xB1);
    v = DPP_ADD(v, 0x4E);
    v = DPP_ADD(v, 0x141);
    v = DPP_ADD(v, 0x140);
    const float r0 = __builtin_bit_cast(float, __builtin_amdgcn_readlane(__builtin_bit_cast(int, v), 0)), r1 = __builtin_bit_cast(float, __builtin_amdgcn_readlane(__builtin_bit_cast(int, v), 16));
    const float r2 = __builtin_bit_cast(float, __builtin_amdgcn_readlane(__builtin_bit_cast(int, v), 32)), r3 = __builtin_bit_cast(float, __builtin_amdgcn_readlane(__builtin_bit_cast(int, v), 48));
    return (r0 + r1) + (r2 + r3);
}
__device__ __forceinline__ float silu_f(float x) { return x / (1.f + __expf(-x)); }
__device__ __forceinline__ float sigmoid_f(float x) { return 1.f / (1.f + __expf(-x)); }
__device__ __forceinline__ int opaque_tid() { int t = threadIdx.x; asm volatile("" : "+v"(t)); return t; }
__device__ __forceinline__ int tok_kind(int r) { return r < NPT ? 0 : 1 + ((r - NPT) >> 10); }

template <bool WIN> __device__ __forceinline__ void p0_transpose_item(const float* W, int ldw, int K, int N, bf16* WT, float* scr, int item, int lane) {
    const int nblk = N / 32, kb = item / nblk, nb = item % nblk, k0 = 64 * kb, n0 = 32 * nb;
    const int ns = !WIN ? n0 : (n0 < 768 ? n0 : (n0 < 2816 ? n0 + 768 : n0 - 2048));
    float wv[32];
#pragma unroll
    for (int i = 0; i < 32; ++i) { const int kk = 2 * i + (lane >> 5); wv[i] = W[(size_t)(k0 + kk) * ldw + ns + (lane & 31)]; }
#pragma unroll
    for (int i = 0; i < 32; ++i) { const int kk = 2 * i + (lane >> 5); scr[kk * 33 + (lane & 31)] = wv[i]; }
    asm volatile("s_waitcnt lgkmcnt(0)" ::: "memory");
    const int c = lane & 7;
#pragma unroll
    for (int j = 0; j < 4; ++j) { const int n = (lane >> 3) + 8 * j; const float* s = scr + (8 * c) * 33 + n;
        u32x4 o; o.x = pk2(s[0 * 33], s[1 * 33]); o.y = pk2(s[2 * 33], s[3 * 33]); o.z = pk2(s[4 * 33], s[5 * 33]); o.w = pk2(s[6 * 33], s[7 * 33]);
        *(u32x4*)(WT + (size_t)(n0 + n) * K + k0 + 8 * c) = o; }
    asm volatile("s_waitcnt lgkmcnt(0)" ::: "memory");
}

constexpr int TR_IN = 16 * 112, TR_O = 16 * 32, TR_1 = 16 * 128, TR_2 = 64 * 32, TR_PER = TR_IN + TR_O + TR_1 + TR_2;
constexpr int TR_DEFER_ITEMS = (TR_PER - TR_IN + 63) / 64;
constexpr int TR_L1_ITEMS = TR_PER / 64;
#ifndef TR_QUOTA
#define TR_QUOTA 5
#endif
__device__ __forceinline__ void p0_transpose_any(CArgs& a, float* scr, int it, int lane) {
    unsigned char* ws = a.ws;
    const int l = it / TR_PER; int r = it % TR_PER;
    if (r < TR_IN) { p0_transpose_item<true>(a.in[I_WIN] + (size_t)l * 1024 * NIN, NIN, 1024, NPROJ, (bf16*)(ws + WS_WIN) + (size_t)l * NPROJ * 1024, scr, r, lane); return; } r -= TR_IN;
    if (r < TR_O) { p0_transpose_item<false>(a.in[I_WOUT] + (size_t)l * 1024 * 1024, 1024, 1024, 1024, (bf16*)(ws + WS_WOUT) + (size_t)l * 1024 * 1024, scr, r, lane); return; } r -= TR_O;
    if (r < TR_1) { p0_transpose_item<false>(a.in[I_W1] + (size_t)l * 1024 * DFF, DFF, 1024, DFF, (bf16*)(ws + WS_W1) + (size_t)l * DFF * 1024, scr, r, lane); return; } r -= TR_1;
    p0_transpose_item<false>(a.in[I_W2] + (size_t)l * DFF * 1024, 1024, DFF, 1024, (bf16*)(ws + WS_W2) + (size_t)l * 1024 * DFF, scr, r, lane);
}
__device__ __forceinline__ void filter_block_item(CArgs& a, unsigned char* lds, int it) {
    const int tid = opaque_tid(), lane = tid & 63, wave = __builtin_amdgcn_readfirstlane(tid >> 6);
    unsigned char* ws = a.ws; float* fl = (float*)lds;
    __syncthreads();
        const int l = it / 80, r = it % 80, Lsel = r >= 16, mb = Lsel ? r - 16 : r, L = Lsel ? 1024 : 256, m0 = mb * 16;
        float* z = fl;
        float* h1 = fl + 16 * 33;
        float* h2 = h1 + 16 * 64;
        if (tid < 256) { const int mi = tid >> 4, band = (tid & 15) + 1, m = m0 + mi; const int ph = (m * band) % L;
            float sn, cs; sincospif(2.0f * (float)ph / (float)L, &sn, &cs);
            z[mi * 33 + band] = cs; z[mi * 33 + 16 + band] = -sn; if (band == 1) z[mi * 33] = (float)m / (float)(L - 1); }
        __syncthreads();
        const float* w1 = a.in[I_HW1] + l * 33 * 64; const float* w2 = a.in[I_HW2] + l * 64 * 64; const float* w3 = a.in[I_HW3] + (size_t)l * 64 * 1024;
        { const int j = tid & 63; const float fj = a.in[I_HFREQ][l * 64 + j], bj = a.in[I_HB1][l * 64 + j];
          float wc[33];
#pragma unroll
          for (int k = 0; k < 33; ++k) wc[k] = w1[k * 64 + j];
#pragma unroll
          for (int h = 0; h < 2; ++h) { const int mi = (tid >> 6) + 8 * h; float d = bj;
#pragma unroll
              for (int k = 0; k < 33; ++k) d += z[mi * 33 + k] * wc[k];
              h1[mi * 64 + j] = sinf(fj * d); } }
        __syncthreads();
        { const int j = tid & 63; const float fj = a.in[I_HFREQ][l * 64 + j], bj = a.in[I_HB2][l * 64 + j];
          float wc[64];
#pragma unroll
          for (int k = 0; k < 64; ++k) wc[k] = w2[k * 64 + j];
#pragma unroll
          for (int h = 0; h < 2; ++h) { const int mi = (tid >> 6) + 8 * h; float d = bj;
#pragma unroll
              for (int k = 0; k < 64; ++k) d += h1[mi * 64 + k] * wc[k];
              h2[mi * 64 + j] = sinf(fj * d); } }
        __syncthreads();
        float* Gf = (float*)(ws + WS_FILT) + (size_t)l * FILT_L + (Lsel ? 262144 : 0);
#pragma unroll 1
        for (int h = 0; h < 2; ++h) { const int col = 64 * (wave + 8 * h) + lane, o = col >> 9, dd = (col >> 8) & 1, c = col & 255;
            float acc[16];
#pragma unroll
            for (int mi = 0; mi < 16; ++mi) acc[mi] = 0.f;
#pragma unroll 1
            for (int k0 = 0; k0 < 64; k0 += 32) { float wv[32];
#pragma unroll
                for (int kk = 0; kk < 32; ++kk) wv[kk] = w3[(k0 + kk) * 1024 + col];
#pragma unroll
                for (int kk = 0; kk < 32; ++kk)
#pragma unroll
                    for (int mi = 0; mi < 16; ++mi) acc[mi] += h2[mi * 64 + k0 + kk] * wv[kk]; }
            const float la = logf(1e-2f) / 1.5f, lb = logf(1e-2f) / 0.3f; const float delta = fabsf(la + (float)c * ((lb - la) / 255.0f));
            float* gp = Gf + (size_t)(o * 256 + c) * (2 * L) + L;
#pragma unroll
            for (int mi = 0; mi < 16; ++mi) { const int m = m0 + mi; const float t = (float)m / (float)(L - 1); const float v = acc[mi] * expf(-t * delta);
                if (dd == 0) gp[m] = v; else if (m > 0) gp[-m] = v; } }
        __syncthreads();
}
__device__ __forceinline__ void p0_prologue(CArgs& a, unsigned char* lds) {
    const int tid = threadIdx.x, lane = tid & 63, wave = tid >> 6, G = gridDim.x, bid = blockIdx.x;
    unsigned char* ws = a.ws;
    float* fl = (float*)lds;
    bool have_svec = false;
    const bool pv = a.ph_hi >= 1000;
#ifndef PV
#define PV 0
#endif
    for (int it = bid; it < 192; it += G) {
        if (!have_svec) {
            for (int i = tid; i < 3 * 1024; i += 512) { const int kind = i >> 10, k = i & 1023; const float v = kind == 0 ? a.in[I_CCTX][k] : a.in[I_C][(kind - 1) * 1024 + k]; fl[i] = silu_f(v); }
            have_svec = true;
        }
        __syncthreads();
        const int l = it / 96, cgp = it % 96;
        const float* W = a.in[I_ADAW] + (size_t)l * 1024 * 6144 + cgp * 64;
        const int c4 = lane & 15, kr = lane >> 4;
        f32x4 acc[3]; acc[0] = acc[1] = acc[2] = (f32x4){0.f, 0.f, 0.f, 0.f};
#pragma unroll 8
        for (int i = 0; i < 32; ++i) { const int k = wave * 128 + 4 * i + kr; const f32x4 w = *(const f32x4*)(W + (size_t)k * 6144 + 4 * c4);
            acc[0] += w * fl[k]; acc[1] += w * fl[1024 + k]; acc[2] += w * fl[2048 + k]; }
#pragma unroll
        for (int kd = 0; kd < 3; ++kd)
#pragma unroll
            for (int e = 0; e < 4; ++e) { float v = acc[kd][e]; v += __shfl_xor(v, 16); v += __shfl_xor(v, 32); acc[kd][e] = v; }
        float* red = fl + 3072;
        if (kr == 0) {
#pragma unroll
            for (int kd = 0; kd < 3; ++kd)
#pragma unroll
                for (int e = 0; e < 4; ++e) red[(wave * 3 + kd) * 64 + 4 * c4 + e] = acc[kd][e];
        }
        __syncthreads();
        if (tid < 192) { const int kd = tid >> 6, c = tid & 63; float s = a.in[I_ADAB][l * 6144 + cgp * 64 + c];
#pragma unroll
            for (int w = 0; w < 8; ++w) s += red[(w * 3 + kd) * 64 + c];
            ((float*)(ws + WS_MOD))[(l * 3 + kd) * 6144 + cgp * 64 + c] = s; }
        asm volatile("s_waitcnt vmcnt(0)" ::: "memory");
        __syncthreads();
        if (tid == 0) { __builtin_amdgcn_fence(__ATOMIC_RELEASE, "agent"); asm volatile("s_waitcnt vmcnt(0)" ::: "memory"); (void)__hip_atomic_fetch_add((unsigned*)(ws + WS_CTL) + 64 * 11, 1u, __ATOMIC_RELAXED, __HIP_MEMORY_SCOPE_AGENT); }
    }
    __syncthreads();
    {
        float* scr = fl + wave * 4096;
        if (!(pv && PV == 4)) for (int it = bid * 8 + wave; it < TR_IN; it += G * 8) p0_transpose_any(a, scr, it, lane);
    }
    __syncthreads();
    if (!(pv && PV == 1)) for (int it = (G - 1 - bid); it < 80; it += G) filter_block_item(a, lds, it);
    __syncthreads();
}
__device__ __forceinline__ int trq_fetch(CArgs& a, unsigned char* lds) {
    volatile unsigned* slot = (volatile unsigned*)(lds + LDS_BYTES - 192);
    __syncthreads();
    if (threadIdx.x == 0) *slot = atomicAdd((unsigned*)(a.ws + WS_CTL) + 64 * 9, 1u);
    __syncthreads();
    return __builtin_amdgcn_readfirstlane((int)*slot);
}
__device__ __forceinline__ void transpose_block_item(CArgs& a, unsigned char* lds, int item, int base = TR_IN, int lim = TR_PER) {
    const int tid = opaque_tid(), lane = tid & 63, wave = __builtin_amdgcn_readfirstlane(tid >> 6);
    float* scr = (float*)lds + wave * 4096;
    __syncthreads();
#pragma unroll 1
    for (int k = 0; k < 8; ++k) { const int it = base + 64 * item + wave * 8 + k; if (it < lim) p0_transpose_any(a, scr, it, lane); }
}

__device__ __forceinline__ float bperm_xor(float v, int lane, int k) { return __builtin_bit_cast(float, __builtin_amdgcn_ds_bpermute((lane ^ k) << 2, __builtin_bit_cast(int, v))); }
__device__ __forceinline__ float fold16(const float (&p)[16], int lane) {
    float q8[8], q4[4], q2[2];
    const bool b5 = lane & 32, b4 = lane & 16, b3 = lane & 8, b2 = lane & 4;
#pragma unroll
    for (int i = 0; i < 8; ++i) { const float send = b5 ? p[i] : p[8 + i], keep = b5 ? p[8 + i] : p[i]; q8[i] = keep + bperm_xor(send, lane, 32); }
#pragma unroll
    for (int i = 0; i < 4; ++i) { const float send = b4 ? q8[i] : q8[4 + i], keep = b4 ? q8[4 + i] : q8[i]; q4[i] = keep + bperm_xor(send, lane, 16); }
#pragma unroll
    for (int i = 0; i < 2; ++i) { const float send = b3 ? q4[i] : q4[2 + i], keep = b3 ? q4[2 + i] : q4[i]; q2[i] = keep + bperm_xor(send, lane, 8); }
    float v = (b2 ? q2[1] : q2[0]) + bperm_xor(b2 ? q2[0] : q2[1], lane, 4);
    v = DPP_ADD(v, 0x4E); v = DPP_ADD(v, 0xB1);
    return v;
}
__device__ __forceinline__ void norm_wg_load(CArgs& a, unsigned char* lds, int l) {
    float* wg = (float*)lds; const int tid = threadIdx.x;
    const float* W = a.in[I_WIN] + (size_t)l * 1024 * NIN + NPROJ;
    for (int i = tid; i < 4096; i += 512) { const int k = i >> 2, j4 = i & 3; const f32x4 v = *(const f32x4*)(W + (size_t)k * NIN + 4 * j4);
        wg[(4 * j4 + 0) * 1024 + k] = v.x; wg[(4 * j4 + 1) * 1024 + k] = v.y; wg[(4 * j4 + 2) * 1024 + k] = v.z; wg[(4 * j4 + 3) * 1024 + k] = v.w; }
    __syncthreads();
}
template <int MODE, bool GATES, bool FINAL>
__device__ __forceinline__ void norm_rows(CArgs& a, unsigned char* lds, int l, int which, int first, int stride, int rend, bool load_wg = true) {
    const int tid = opaque_tid(), lane = tid & 63;
    float* X = a.ph_hi >= 1000 ? (float*)(a.ws + WS_PROJ) : a.out; bf16* U = (bf16*)(a.ws + WS_U); float* GT = (float*)(a.ws + WS_GATES);
    const float* mod = (const float*)(a.ws + WS_MOD) + (size_t)l * 3 * 6144;
    float* wg = (float*)lds;
    if (GATES && load_wg) norm_wg_load(a, lds, l);
    const float* gvec = FINAL ? a.in[I_NFG] : (which == 1 ? a.in[I_N1G] + l * 1024 : a.in[I_N2G] + l * 1024);
    constexpr int RB = GATES ? 1 : 5;
    for (int r0 = first; r0 < rend; r0 += stride * RB) {
        f32x4 vv[5][4];
#pragma unroll
        for (int k = 0; k < RB; ++k) { int r = r0 + k * stride; r = r < rend ? r : rend - 1;
            const float* src = (MODE == 0) ? (r < NPT ? a.in[I_XP] + (size_t)r * D : a.in[I_XS] + (size_t)(r - NPT) * D) : X + (size_t)r * D;
#pragma unroll
            for (int j = 0; j < 4; ++j) vv[k][j] = *(const f32x4*)(src + 4 * lane + 256 * j); }
#define NORM_ROW(KK) if (KK < RB) { const int r = r0 + KK * stride; if (r < rend) {\
            f32x4 v[4]; v[0] = vv[KK][0]; v[1] = vv[KK][1]; v[2] = vv[KK][2]; v[3] = vv[KK][3];\
            if (MODE == 0) {\
                if (r >= NPT) { const int t = (r - NPT) & 1023; const float pr = (float)(t >> 6), pc = (float)(t & 63);\
            _Pragma("unroll")\
                    for (int j = 0; j < 4; ++j) { const float p = (j < 2) ? pr : pc;\
            _Pragma("unroll")\
                        for (int e = 0; e < 4; ++e) { const int i = 4 * lane + e; const float om = __builtin_amdgcn_exp2f((float)i * (-13.287712379549449f / 256.0f)); const float ang = p * om; v[j][e] += (j & 1) ? __cosf(ang) : __sinf(ang); } } }\
            _Pragma("unroll")\
                for (int j = 0; j < 4; ++j) *(f32x4*)(X + (size_t)r * D + 4 * lane + 256 * j) = v[j];\
            }\
            float ss = 0.f;\
            _Pragma("unroll")\
            for (int j = 0; j < 4; ++j) ss += (v[j].x * v[j].x + v[j].y * v[j].y) + (v[j].z * v[j].z + v[j].w * v[j].w);\
            const float rstd = 1.0f / sqrtf(wave_sum(ss) * (1.0f / D) + EPS);\
            if (FINAL) {\
            _Pragma("unroll")\
                for (int j = 0; j < 4; ++j) { const f32x4 g = *(const f32x4*)(gvec + 4 * lane + 256 * j); *(f32x4*)(X + (size_t)r * D + 4 * lane + 256 * j) = v[j] * rstd * g; }\
            } else {\
            const int kind = tok_kind(r);\
            const float* sh = mod + kind * 6144 + (which == 1 ? 0 : 3072); const float* sc = sh + 1024;\
            _Pragma("unroll")\
            for (int j = 0; j < 4; ++j) { const int c = 4 * lane + 256 * j; const f32x4 g = *(const f32x4*)(gvec + c), s1 = *(const f32x4*)(sc + c), s0 = *(const f32x4*)(sh + c);\
                v[j] = v[j] * rstd * g * (s1 + 1.0f) + s0;\
                u32x2 o; o.x = cvtpk(v[j].x, v[j].y); o.y = cvtpk(v[j].z, v[j].w); *(u32x2*)(U + (size_t)r * D + c) = o; }\
            if (GATES) {\
                float p16[16];\
            _Pragma("unroll")\
                for (int g = 0; g < 16; ++g) p16[g] = 0.f;\
            _Pragma("unroll")\
                for (int j = 0; j < 4; ++j) {\
            _Pragma("unroll")\
                    for (int g = 0; g < 8; ++g) { const f32x4 w = *(const f32x4*)(wg + g * 1024 + 4 * lane + 256 * j); p16[g] += (v[j].x * w.x + v[j].y * w.y) + (v[j].z * w.z + v[j].w * w.w); }\
                    __builtin_amdgcn_sched_barrier(0);\
            _Pragma("unroll")\
                    for (int g = 8; g < 16; ++g) { const f32x4 w = *(const f32x4*)(wg + g * 1024 + 4 * lane + 256 * j); p16[g] += (v[j].x * w.x + v[j].y * w.y) + (v[j].z * w.z + v[j].w * w.w); }\
                    __builtin_amdgcn_sched_barrier(0); }\
                { const float tot = fold16(p16, lane); const int gi = ((lane >> 5) & 1) * 8 + ((lane >> 4) & 1) * 4 + ((lane >> 3) & 1) * 2 + ((lane >> 2) & 1);\
                  if ((lane & 3) == 0) GT[(size_t)r * 16 + gi] = tot + a.in[I_MLGB][l * 16 + gi]; }\
            }\
            } } }
        NORM_ROW(0) NORM_ROW(1) NORM_ROW(2) NORM_ROW(3) NORM_ROW(4)
#undef NORM_ROW
    }
}

template <int MODE, bool GATES, bool FINAL>
__device__ __forceinline__ void norm_phase(CArgs& a, unsigned char* lds, int l, int which) {
    norm_rows<MODE, GATES, FINAL>(a, lds, l, which, blockIdx.x * 8 + (threadIdx.x >> 6), gridDim.x * 8, NTOK);
}

template <int ACT> struct EpiBf16 {
    static constexpr bool PERM = true, AFTER_DRAIN = false;
    bf16* O; int ldc;
    __device__ __forceinline__ void operator()(const pg8::f32x4 (&acc)[2][2][4][2], const pg8::Unit& u, int wr, int wc, int fr, int fq) const {
        const int row0 = u.pm * 256 + wr * 64 + fr, col0 = u.pn * 256 + wc * 32 + 8 * fq;
#pragma unroll
        for (int ai = 0; ai < 2; ++ai)
#pragma unroll
            for (int m = 0; m < 4; ++m) { bf16* rowp = O + (size_t)(row0 + ai * 128 + m * 16) * ldc + col0;
#pragma unroll
                for (int bj = 0; bj < 2; ++bj) { pg8::f32x4 v0 = acc[ai][bj][m][0], v1 = acc[ai][bj][m][1];
                    if (ACT == 1) {
#pragma unroll
                        for (int e = 0; e < 4; ++e) { const float p = fmaxf(v0[e], 0.f), q = fmaxf(v1[e], 0.f); v0[e] = p * p; v1[e] = q * q; } }
                    u32x4 w; w.x = pg8::cvt_pk_bf16(v0[0], v0[1]); w.y = pg8::cvt_pk_bf16(v0[2], v0[3]); w.z = pg8::cvt_pk_bf16(v1[0], v1[1]); w.w = pg8::cvt_pk_bf16(v1[2], v1[3]);
                    *(u32x4*)(rowp + bj * 128) = w; } }
    }
};
struct EpiResid {
    static constexpr bool PERM = false, AFTER_DRAIN = false;
    float* X; const float* gate;
    __device__ __forceinline__ void operator()(const pg8::f32x4 (&acc)[2][2][4][2], const pg8::Unit& u, int wr, int wc, int fr, int fq) const {
        const int row0 = u.pm * 256 + wr * 64 + fr, col0 = u.pn * 256 + wc * 32 + 4 * fq;
        const int kind = u.pm < 32 ? 0 : 1 + ((u.pm - 32) >> 2);
        pg8::f32x4 gv[2][2];
#pragma unroll
        for (int bj = 0; bj < 2; ++bj)
#pragma unroll
            for (int n = 0; n < 2; ++n) gv[bj][n] = *(const pg8::f32x4*)(gate + kind * 6144 + col0 + bj * 128 + n * 16);
#pragma unroll
        for (int ai = 0; ai < 2; ++ai) {
            pg8::f32x4 xv[4][2][2];
#pragma unroll
            for (int m = 0; m < 4; ++m) { const float* rowp = X + (size_t)(row0 + ai * 128 + m * 16) * D + col0;
#pragma unroll
                for (int bj = 0; bj < 2; ++bj)
#pragma unroll
                    for (int n = 0; n < 2; ++n) xv[m][bj][n] = *(const pg8::f32x4*)(rowp + bj * 128 + n * 16); }
#pragma unroll
            for (int m = 0; m < 4; ++m) { float* rowp = X + (size_t)(row0 + ai * 128 + m * 16) * D + col0;
#pragma unroll
                for (int bj = 0; bj < 2; ++bj)
#pragma unroll
                    for (int n = 0; n < 2; ++n) *(pg8::f32x4*)(rowp + bj * 128 + n * 16) = xv[m][bj][n] + gv[bj][n] * acc[ai][bj][m][n]; } }
    }
};

__device__ __forceinline__ void gates_block_item(CArgs& a, unsigned char* lds, int l, int item) {
    const int tid = opaque_tid(), lane = tid & 63, wave = __builtin_amdgcn_readfirstlane(tid >> 6);
    const bf16* U = (const bf16*)(a.ws + WS_U); float* GT = (float*)(a.ws + WS_GATES); const float* wg = (const float*)lds;
    const int gi = ((lane >> 5) & 1) * 8 + ((lane >> 4) & 1) * 4 + ((lane >> 3) & 1) * 2 + ((lane >> 2) & 1);
    const float gb = a.in[I_MLGB][l * 16 + gi];
    u32x2 raw[5][4];
#pragma unroll
    for (int k = 0; k < 5; ++k) { const int r = 40 * item + wave + 8 * k;
#pragma unroll
        for (int j = 0; j < 4; ++j) raw[k][j] = *(const u32x2*)(U + (size_t)r * D + 4 * lane + 256 * j); }
#pragma unroll
    for (int k = 0; k < 5; ++k) { const int r = 40 * item + wave + 8 * k;
        float p16[16];
#pragma unroll
        for (int g = 0; g < 16; ++g) p16[g] = 0.f;
#pragma unroll
        for (int j = 0; j < 4; ++j) { const float v0 = bflo(raw[k][j].x), v1 = bfhi(raw[k][j].x), v2 = bflo(raw[k][j].y), v3 = bfhi(raw[k][j].y);
#pragma unroll
            for (int g = 0; g < 8; ++g) { const f32x4 w = *(const f32x4*)(wg + g * 1024 + 4 * lane + 256 * j); p16[g] += (v0 * w.x + v1 * w.y) + (v2 * w.z + v3 * w.w); }
            __builtin_amdgcn_sched_barrier(0);
#pragma unroll
            for (int g = 8; g < 16; ++g) { const f32x4 w = *(const f32x4*)(wg + g * 1024 + 4 * lane + 256 * j); p16[g] += (v0 * w.x + v1 * w.y) + (v2 * w.z + v3 * w.w); }
            __builtin_amdgcn_sched_barrier(0); }
        const float tot = fold16(p16, lane);
        if ((lane & 3) == 0) GT[(size_t)r * 16 + gi] = tot + gb; }
}
__device__ __forceinline__ bool first_unit(int nM, int nN, int c, pg8::Unit& u) {
    const int nwg = nM * nN; if (c >= nwg) return false;
    int wgid = c; { const int q = nwg / pg8::NXCD, r = nwg % pg8::NXCD, xcd = wgid % pg8::NXCD, off = wgid / pg8::NXCD; wgid = (xcd < r ? xcd * (q + 1) : r * (q + 1) + (xcd - r) * q) + off; }
    const int nig = pg8::WGM * nN, gid = wgid / nig, fm = gid * pg8::WGM, gsz = (nM - fm) < pg8::WGM ? (nM - fm) : pg8::WGM;
    u.pm = fm + ((wgid % nig) % gsz); u.pn = (wgid % nig) / gsz; return true;
}
template <bool GATES, bool FINAL>
__device__ __forceinline__ void panel_norm(CArgs& a, unsigned char* lds, int l, int which, int pm, int quarter) {
    const int tid = threadIdx.x, lane = tid & 63, wave = tid >> 6;
    float* X = a.ph_hi >= 1000 ? (float*)(a.ws + WS_PROJ) : a.out; bf16* U = (bf16*)(a.ws + WS_U); float* GT = (float*)(a.ws + WS_GATES);
    float* wg = (float*)lds;
    if (GATES) {
        const float* W = a.in[I_WIN] + (size_t)l * 1024 * NIN + NPROJ;
        for (int i = tid; i < 4096; i += 512) { const int k = i >> 2, j4 = i & 3; const f32x4 v = *(const f32x4*)(W + (size_t)k * NIN + 4 * j4);
            wg[(4 * j4 + 0) * 1024 + k] = v.x; wg[(4 * j4 + 1) * 1024 + k] = v.y; wg[(4 * j4 + 2) * 1024 + k] = v.z; wg[(4 * j4 + 3) * 1024 + k] = v.w; }
        __syncthreads();
    }
    const int kind = pm < 32 ? 0 : 1 + ((pm - 32) >> 2);
    const float* gvec = FINAL ? a.in[I_NFG] : (which == 1 ? a.in[I_N1G] + l * 1024 : a.in[I_N2G] + l * 1024);
    const float* sh = (const float*)(a.ws + WS_MOD) + (size_t)l * 3 * 6144 + kind * 6144 + (which == 1 ? 0 : 3072); const float* sc = sh + 1024;
    f32x4 gs[4], s0[4];
#pragma unroll
    for (int j = 0; j < 4; ++j) { const int c = 4 * lane + 256 * j; gs[j] = *(const f32x4*)(gvec + c);
        if (!FINAL) { gs[j] = gs[j] * (*(const f32x4*)(sc + c) + 1.0f); s0[j] = *(const f32x4*)(sh + c); } else s0[j] = (f32x4){0.f, 0.f, 0.f, 0.f}; }
    float gb = 0.f; if (GATES) gb = a.in[I_MLGB][l * 16 + ((lane >> 5) & 1) * 8 + ((lane >> 4) & 1) * 4 + ((lane >> 3) & 1) * 2 + ((lane >> 2) & 1)];
    const int rbase = pm * 256 + quarter * 64 + wave * 8;
    constexpr int NB = GATES ? 1 : 8;
#pragma unroll 1
    for (int b = 0; b < 8 / NB; ++b) {
        f32x4 vv[NB][4];
#pragma unroll
        for (int k = 0; k < NB; ++k)
#pragma unroll
            for (int j = 0; j < 4; ++j) vv[k][j] = *(const f32x4*)(X + (size_t)(rbase + NB * b + k) * D + 4 * lane + 256 * j);
#pragma unroll
        for (int k = 0; k < NB; ++k) { const int r = rbase + NB * b + k;
            float ss = 0.f;
#pragma unroll
            for (int j = 0; j < 4; ++j) ss += (vv[k][j].x * vv[k][j].x + vv[k][j].y * vv[k][j].y) + (vv[k][j].z * vv[k][j].z + vv[k][j].w * vv[k][j].w);
            const float rstd = 1.0f / sqrtf(wave_sum(ss) * (1.0f / D) + EPS);
            f32x4 v[4];
#pragma unroll
            for (int j = 0; j < 4; ++j) { v[j] = vv[k][j] * rstd * gs[j] + s0[j];
                if (FINAL) *(f32x4*)(X + (size_t)r * D + 4 * lane + 256 * j) = v[j];
                else { u32x2 o; o.x = cvtpk(v[j].x, v[j].y); o.y = cvtpk(v[j].z, v[j].w); *(u32x2*)(U + (size_t)r * D + 4 * lane + 256 * j) = o; } }
            if (GATES) { float p[16];
#pragma unroll
                for (int g = 0; g < 16; ++g) p[g] = 0.f;
#pragma unroll
                for (int j = 0; j < 4; ++j) {
#pragma unroll
                    for (int g = 0; g < 8; ++g) { const f32x4 w = *(const f32x4*)(wg + g * 1024 + 4 * lane + 256 * j); p[g] += (v[j].x * w.x + v[j].y * w.y) + (v[j].z * w.z + v[j].w * w.w); }
                    __builtin_amdgcn_sched_barrier(0);
#pragma unroll
                    for (int g = 8; g < 16; ++g) { const f32x4 w = *(const f32x4*)(wg + g * 1024 + 4 * lane + 256 * j); p[g] += (v[j].x * w.x + v[j].y * w.y) + (v[j].z * w.z + v[j].w * w.w); }
                    __builtin_amdgcn_sched_barrier(0); }
                const float tot = fold16(p, lane);
                if ((lane & 3) == 0) GT[(size_t)r * 16 + ((lane >> 5) & 1) * 8 + ((lane >> 4) & 1) * 4 + ((lane >> 3) & 1) * 2 + ((lane >> 2) & 1)] = tot + gb; }
        }
    }
}
template <bool GATES, bool FINAL>
__device__ __forceinline__ void panel_tail(CArgs& a, unsigned char* lds, int l, int which, unsigned* cnt_bank, const pg8::StaticOrder& S) {
    pg8::Unit u; if (!first_unit(NTOK / 256, 4, (int)blockIdx.x, u)) return;
    if (threadIdx.x == 0) {
        __builtin_amdgcn_fence(__ATOMIC_RELEASE, "agent");
        asm volatile("s_waitcnt vmcnt(0)" ::: "memory");
        unsigned* c = cnt_bank + 64 * u.pm;
        (void)__hip_atomic_fetch_add(c, 1u, __ATOMIC_RELAXED, __HIP_MEMORY_SCOPE_AGENT);
        unsigned spins = 0;
        while (__hip_atomic_load(c, __ATOMIC_RELAXED, __HIP_MEMORY_SCOPE_AGENT) < 4u && ++spins < (1u << 22)) __builtin_amdgcn_s_sleep(1);
        __builtin_amdgcn_fence(__ATOMIC_ACQUIRE, "agent"); asm volatile("s_waitcnt vmcnt(0)" ::: "memory");
    }
    __syncthreads();
    panel_norm<GATES, FINAL>(a, lds, l, which, u.pm, u.pn);
}

__device__ __forceinline__ float conv3_at(const bf16* base, int ld, int t, int L, int col, float w0, float w1, float w2) {
    float r = w1 * bflo(base[(size_t)t * ld + col]);
    if (t > 0) r += w0 * bflo(base[(size_t)(t - 1) * ld + col]);
    if (t < L - 1) r += w2 * bflo(base[(size_t)(t + 1) * ld + col]);
    return r;
}

__device__ __forceinline__ void sc_item(CArgs& a, int l, int item) {
    const bf16* P = (const bf16*)(a.ws + WS_PROJ); bf16* Y = (bf16*)(a.ws + WS_Y);
    const int idx = item * 512 + opaque_tid();
    const int tok = idx >> 5, c0 = (idx & 31) * 8;
    const int t = tok < NPT ? (tok & 255) : ((tok - NPT) & 1023), L = tok < NPT ? LP : LS;
    const float* w = a.in[I_SCW] + l * 3 * 256;
    float bg[8], cx[3][8];
    unpack8(ld8(P + (size_t)tok * PLD + c0), bg);
#pragma unroll
    for (int j = 0; j < 3; ++j) { const int tt = t + j - 1; const bool ok = tt >= 0 && tt < L; const int tk = ok ? tok + j - 1 : tok;
        float cgv[8], xi[8]; unpack8(ld8(P + (size_t)tk * PLD + 256 + c0), cgv); unpack8(ld8(P + (size_t)tk * PLD + 512 + c0), xi);
#pragma unroll
        for (int e = 0; e < 8; ++e) cx[j][e] = ok ? cgv[e] * xi[e] : 0.f; }
    float y[8];
#pragma unroll
    for (int e = 0; e < 8; ++e) y[e] = bg[e] * (w[c0 + e] * cx[0][e] + w[256 + c0 + e] * cx[1][e] + w[512 + c0 + e] * cx[2][e]);
    u32x4 o; o.x = pk2(y[0], y[1]); o.y = pk2(y[2], y[3]); o.z = pk2(y[4], y[5]); o.w = pk2(y[6], y[7]);
    *(u32x4*)(Y + (size_t)tok * D + c0) = o;
}

typedef short bf16x8 __attribute__((ext_vector_type(8)));
typedef short s16x4 __attribute__((ext_vector_type(4)));
typedef float f32x16 __attribute__((ext_vector_type(16)));
#define MFMA32(a, b, c) __builtin_amdgcn_mfma_f32_32x32x16_bf16((a), (b), (c), 0, 0, 0)
template <int S> __device__ __forceinline__ bf16x8 pack8(const f32x16& x) { u32x4 p; p.x = cvtpk(x[8 * S], x[8 * S + 1]); p.y = cvtpk(x[8 * S + 2], x[8 * S + 3]); p.z = cvtpk(x[8 * S + 4], x[8 * S + 5]); p.w = cvtpk(x[8 * S + 6], x[8 * S + 7]); return __builtin_bit_cast(bf16x8, p); }
__device__ __forceinline__ int tswz(int row, int blk) { return row * 72 + ((blk ^ ((row >> 3) & 7)) << 3); }
__device__ __forceinline__ bf16x8 perm_frag(const bf16x8 f) { u32x4 u = __builtin_bit_cast(u32x4, f); const auto p = __builtin_amdgcn_permlane32_swap(u.x, u.z, false, false), q = __builtin_amdgcn_permlane32_swap(u.y, u.w, false, false);
    u.x = p[0]; u.z = p[1]; u.y = q[0]; u.w = q[1]; return __builtin_bit_cast(bf16x8, u); }
__device__ __forceinline__ bf16x8 join8(s16x4 lo, s16x4 hi) { return __builtin_shufflevector(lo, hi, 0, 1, 2, 3, 4, 5, 6, 7); }

template <int VAR> __device__ __forceinline__ void mlstm_item_mfma(CArgs& a, unsigned char* lds, int l, int item) {
    const int tid = opaque_tid(), lane = tid & 63, wave = __builtin_amdgcn_readfirstlane(tid >> 6), dvb = wave & 3, tb = wave >> 2, r = lane & 31, h = lane >> 5;
    int seq, hd;
    if (item < 16) { seq = 32 + item / 8; hd = item % 8; } else { const int it = item - 16; seq = it / 8; hd = it % 8; }
    const int head = hd >> 1, dir = hd & 1, L = seq < 32 ? LP : LS, tok0 = seq < 32 ? seq * 256 : NPT + (seq - 32) * 1024, nc = L >> 6;
    bf16* Qp = (bf16*)lds; bf16* Kp = (bf16*)(lds + 17408); bf16* KwT = (bf16*)(lds + 34816); bf16* VT = (bf16*)(lds + 53248);
    float* gA = (float*)(lds + 71680); float* gM = gA + 1024; float* gWp = gM + 1024; float* gEm = gWp + 1024; float* gWs = gEm + 1024;
    float* gWc = (float*)(lds + 92160); float* nS0 = gWc + 128; float* cwS = nS0 + 256; float* qnS = cwS + 768;
    const bf16* P = (const bf16*)(a.ws + WS_PROJ) + (size_t)tok0 * PLD + ML_OFF;
    const float* GT = (const float*)(a.ws + WS_GATES) + (size_t)tok0 * 16;
    bf16* HO = (bf16*)(a.ws + (VAR ? (dir ? (234u << 20) : (224u << 20)) : (dir ? WS_HB : WS_HF))) + (size_t)tok0 * 512 + head * 128;
    const float* cw = a.in[I_MLCW] + l * 3 * 1024;
    const size_t sidx = seq >= 32 ? ((((size_t)(seq - 32) * 2 + l) * 2 + dir) * 4 + head) : ((((size_t)seq * 2 + l) * 2 + dir) * 4 + head);
    __syncthreads();
    for (int i = tid; i < 768; i += 512) { const int j = i >> 8, c = i & 255; cwS[i] = cw[j * 1024 + (c < 128 ? head * 128 + c : 512 + head * 128 + (c - 128))]; }
    if (tid < 128) nS0[tid] = seq >= 32 ? a.in[I_SN][sidx * 128 + tid] : 0.f;
    for (int t = tid; t < L; t += 512) { gA[t] = GT[(size_t)t * 16 + dir * 8 + head]; gM[t] = GT[(size_t)t * 16 + dir * 8 + 4 + head]; }
    __syncthreads();
    float* sAl = gWc + 64; float* sBl = sAl + 16; float* sMp = sBl + 16; float* sMf = sMp + 16; float* sWa = gWc + 32;
    for (int ci = wave; ci < nc; ci += 8) {
        const int c = dir ? nc - 1 - ci : ci, s = dir ? 63 - lane : lane, t = 64 * c + s;
        const float ip = gA[t], fp = gM[t];
        const float lf = fminf(fp, 0.f) - __logf(1.f + __expf(-fabsf(fp)));
        float b = lf;
#pragma unroll
        for (int o = 1; o < 64; o <<= 1) { const float x = __shfl_up(b, o); if (lane >= o) b += x; }
        const float av = ip - b; float cm = av;
#pragma unroll
        for (int o = 1; o < 64; o <<= 1) { const float x = __shfl_up(cm, o); if (lane >= o) cm = fmaxf(cm, x); }
        gA[t] = av; gM[t] = cm; gEm[t] = b;
        if (lane == 63) { sAl[ci] = cm; sBl[ci] = b; }
    }
    __syncthreads();
    if (tid == 0) { float mprev = seq >= 32 ? a.in[I_SM][sidx] : 0.f;
        for (int ci = 0; ci < nc; ++ci) { const float Mf = fmaxf(mprev, sAl[ci]); sMp[ci] = mprev; sMf[ci] = Mf; gWc[ci] = __expf(mprev - Mf); sWa[ci] = __expf(fminf(mprev - sAl[ci], 80.f)); mprev = sBl[ci] + Mf; }
        gWc[16] = mprev; }
    __syncthreads();
    for (int t = tid; t < L; t += 512) { const int c = t >> 6, ci = dir ? nc - 1 - c : c; const float mprev = sMp[ci], Mf = sMf[ci];
        const float av = gA[t], b = gEm[t], M = fmaxf(mprev, gM[t]);
        const float Al = sAl[ci];
        gA[t] = __expf(av - Al); gWp[t] = __expf(fminf(Al - M, 80.f)); gEm[t] = __expf(-(b + M)); gWs[t] = __expf(av - Mf); }
    f32x16 Ct[4];
    if (seq >= 32) { const float* C0 = a.in[I_SC] + sidx * 16384;
#pragma unroll
        for (int dkb = 0; dkb < 4; ++dkb)
#pragma unroll
            for (int i = 0; i < 16; ++i) Ct[dkb][i] = C0[(size_t)(32 * dkb + (i & 3) + 8 * (i >> 2) + 4 * h) * 128 + 32 * dvb + r]; }
    else {
#pragma unroll
        for (int dkb = 0; dkb < 4; ++dkb)
#pragma unroll
            for (int i = 0; i < 16; ++i) Ct[dkb][i] = 0.f; }
    __syncthreads();
    const float kscale = 0.08838834764831845f;
    const int tl = 32 * tb + r;
    const int sp = tid >> 4, g8 = (tid & 15) * 8;
    u32x4 Rq[4], Rk[4], Rv[2];
#define ML_ISSUE(CI) do { const int c_ = dir ? nc - 1 - (CI) : (CI); const int t0_ = 64 * c_ + 2 * sp; \
        _Pragma("unroll") for (int j = 0; j < 4; ++j) { int tt = t0_ + j - 1; tt = tt < 0 ? 0 : (tt > L - 1 ? L - 1 : tt); \
            Rq[j] = ld8(P + (size_t)tt * PLD + head * 128 + g8); Rk[j] = ld8(P + (size_t)tt * PLD + 512 + head * 128 + g8); } \
        Rv[0] = ld8(P + (size_t)t0_ * PLD + 1024 + head * 128 + g8); Rv[1] = ld8(P + (size_t)(t0_ + 1) * PLD + 1024 + head * 128 + g8); } while (0)
    ML_ISSUE(0);
#pragma unroll 1
    for (int ci = 0; ci < nc; ++ci) {
        const int c = dir ? nc - 1 - ci : ci, tc0 = 64 * c;
        const float* nS = nS0 + 128 * (ci & 1); float* nSn = nS0 + 128 * ((ci + 1) & 1);
        if (VAR != 1) { const int s0 = 2 * sp, t0 = tc0 + s0;
          const float mlo = t0 > 0 ? 1.f : 0.f, mhi = (t0 + 2 < L) ? 1.f : 0.f;
          float qa[4][8], ka[4][8], q0[8], q1[8], k0[8], k1[8], v0[8], v1[8];
#pragma unroll
          for (int j = 0; j < 4; ++j) { unpack8(Rq[j], qa[j]); unpack8(Rk[j], ka[j]); }
          unpack8(Rv[0], v0); unpack8(Rv[1], v1);
#pragma unroll
          for (int e = 0; e < 8; ++e) { const float a0 = cwS[g8 + e], a1 = cwS[256 + g8 + e], a2 = cwS[512 + g8 + e], b0 = cwS[128 + g8 + e], b1 = cwS[384 + g8 + e], b2 = cwS[640 + g8 + e];
              const float x0 = a0 * mlo * qa[0][e] + a1 * qa[1][e] + a2 * qa[2][e], x1 = a0 * qa[1][e] + a1 * qa[2][e] + a2 * mhi * qa[3][e];
              const float y0 = b0 * mlo * ka[0][e] + b1 * ka[1][e] + b2 * ka[2][e], y1 = b0 * ka[1][e] + b1 * ka[2][e] + b2 * mhi * ka[3][e];
              q0[e] = x0 * __builtin_amdgcn_rcpf(1.f + __expf(-x0)); q1[e] = x1 * __builtin_amdgcn_rcpf(1.f + __expf(-x1));
              k0[e] = y0 * kscale * __builtin_amdgcn_rcpf(1.f + __expf(-y0)); k1[e] = y1 * kscale * __builtin_amdgcn_rcpf(1.f + __expf(-y1)); }
          u32x4 o; o.x = cvtpk(q0[0], q0[1]); o.y = cvtpk(q0[2], q0[3]); o.z = cvtpk(q0[4], q0[5]); o.w = cvtpk(q0[6], q0[7]); *(u32x4*)(Qp + s0 * 136 + g8) = o;
          o.x = cvtpk(q1[0], q1[1]); o.y = cvtpk(q1[2], q1[3]); o.z = cvtpk(q1[4], q1[5]); o.w = cvtpk(q1[6], q1[7]); *(u32x4*)(Qp + (s0 + 1) * 136 + g8) = o;
          o.x = cvtpk(k0[0], k0[1]); o.y = cvtpk(k0[2], k0[3]); o.z = cvtpk(k0[4], k0[5]); o.w = cvtpk(k0[6], k0[7]); *(u32x4*)(Kp + s0 * 136 + g8) = o;
          o.x = cvtpk(k1[0], k1[1]); o.y = cvtpk(k1[2], k1[3]); o.z = cvtpk(k1[4], k1[5]); o.w = cvtpk(k1[6], k1[7]); *(u32x4*)(Kp + (s0 + 1) * 136 + g8) = o;
          { const f32x4 n0 = *(const f32x4*)(nS + g8), n1 = *(const f32x4*)(nS + g8 + 4);
            float p0 = (q0[0] * n0.x + q0[1] * n0.y) + (q0[2] * n0.z + q0[3] * n0.w) + (q0[4] * n1.x + q0[5] * n1.y) + (q0[6] * n1.z + q0[7] * n1.w);
            float p1 = (q1[0] * n0.x + q1[1] * n0.y) + (q1[2] * n0.z + q1[3] * n0.w) + (q1[4] * n1.x + q1[5] * n1.y) + (q1[6] * n1.z + q1[7] * n1.w);
            p0 = DPP_ADD(p0, 0xB1); p1 = DPP_ADD(p1, 0xB1); p0 = DPP_ADD(p0, 0x4E); p1 = DPP_ADD(p1, 0x4E); p0 = DPP_ADD(p0, 0x141); p1 = DPP_ADD(p1, 0x141); p0 = DPP_ADD(p0, 0x140); p1 = DPP_ADD(p1, 0x140);
            if ((tid & 15) == 0) { qnS[s0] = p0; qnS[s0 + 1] = p1; } }
          const float ws0 = gWs[t0], ws1 = gWs[t0 + 1];
#pragma unroll
          for (int e = 0; e < 8; ++e) { const int off = tswz(g8 + e, s0 >> 3) + (s0 & 7); *(unsigned*)(KwT + off) = cvtpk(k0[e] * ws0, k1[e] * ws1); *(unsigned*)(VT + off) = cvtpk(v0[e], v1[e]); } }
        if (ci + 1 < nc) ML_ISSUE(ci + 1);
        __syncthreads();
        const bool skip0 = dir && tb, skip1 = !dir && !tb;
        f32x16 ST0, ST1, acc;
#pragma unroll
        for (int i = 0; i < 16; ++i) { ST0[i] = 0.f; ST1[i] = 0.f; acc[i] = 0.f; }
        float dsum = 0.f; bf16x8 vt[4];
        const float ex = gWp[tc0 + tl], em = gEm[tc0 + tl], pq = qnS[tl], wa = sWa[ci];
#pragma unroll
        for (int k4 = 0; k4 < 4; ++k4) vt[k4] = *(const bf16x8*)(VT + tswz(32 * dvb + r, 2 * k4 + h));
        if (VAR != 2) {
#define LDQ(KK) (*(const bf16x8*)(Qp + tl * 136 + 16 * (KK) + 8 * h))
#define LDK0(KK) (*(const bf16x8*)(Kp + r * 136 + 16 * (KK) + 8 * h))
#define LDK1(KK) (*(const bf16x8*)(Kp + (32 + r) * 136 + 16 * (KK) + 8 * h))
#define ST_STEP(KK, DKB, K2, SK0, SK1) { bf16x8 bqn = bq, a0n = a0, a1n = a1; \
            if ((KK) < 7) { bqn = LDQ((KK) + 1); if (!(SK0)) a0n = LDK0((KK) + 1); if (!(SK1)) a1n = LDK1((KK) + 1); } \
            if (!(SK0)) ST0 = MFMA32(a0, bq, ST0); if (!(SK1)) ST1 = MFMA32(a1, bq, ST1); \
            acc = MFMA32(pack8<K2>(Ct[DKB]), perm_frag(bq), acc); \
            __builtin_amdgcn_sched_barrier(0); bq = bqn; a0 = a0n; a1 = a1n; }
#define ST_ALL(SK0, SK1) { bf16x8 bq = LDQ(0), a0 = bq, a1 = bq; if (!(SK0)) a0 = LDK0(0); if (!(SK1)) a1 = LDK1(0); \
            ST_STEP(0, 0, 0, SK0, SK1) ST_STEP(1, 0, 1, SK0, SK1) ST_STEP(2, 1, 0, SK0, SK1) ST_STEP(3, 1, 1, SK0, SK1) ST_STEP(4, 2, 0, SK0, SK1) ST_STEP(5, 2, 1, SK0, SK1) ST_STEP(6, 3, 0, SK0, SK1) ST_STEP(7, 3, 1, SK0, SK1) }
        if (skip0) ST_ALL(1, 0) else if (skip1) ST_ALL(0, 1) else ST_ALL(0, 0)
#undef ST_ALL
#undef ST_STEP
#undef LDQ
#undef LDK0
#undef LDK1
#pragma unroll
        for (int i = 0; i < 16; ++i) { const int s0 = (i & 3) + 8 * (i >> 2) + 4 * h, s1 = 32 + s0;
            const float e0 = gA[tc0 + s0], e1 = gA[tc0 + s1];
            const bool v0 = tb ? true : (dir ? (s0 >= tl) : (s0 <= tl)), v1 = tb ? (dir ? (s1 >= tl) : (s1 <= tl)) : true;
            ST0[i] = v0 ? ST0[i] * e0 : 0.f; ST1[i] = v1 ? ST1[i] * e1 : 0.f; dsum += ST0[i] + ST1[i]; }
        dsum += __shfl_xor(dsum, 32);
#pragma unroll
        for (int i = 0; i < 16; ++i) acc[i] *= wa;
        if (!skip0) { acc = MFMA32(perm_frag(vt[0]), pack8<0>(ST0), acc); acc = MFMA32(perm_frag(vt[1]), pack8<1>(ST0), acc); }
        if (!skip1) { acc = MFMA32(perm_frag(vt[2]), pack8<0>(ST1), acc); acc = MFMA32(perm_frag(vt[3]), pack8<1>(ST1), acc); }
        }
        { const float den = ex * (dsum + wa * pq), inv = ex / fmaxf(fabsf(den), em);
          bf16* hp = HO + (size_t)(tc0 + tl) * 512 + 32 * dvb + 4 * h;
#pragma unroll
          for (int g4 = 0; g4 < 4; ++g4) { u32x2 o; o.x = cvtpk(acc[4 * g4] * inv, acc[4 * g4 + 1] * inv); o.y = cvtpk(acc[4 * g4 + 2] * inv, acc[4 * g4 + 3] * inv); *(u32x2*)(hp + 8 * g4) = o; } }
        { const float wc = gWc[ci];
#pragma unroll
          for (int dkb = 0; dkb < 4; ++dkb)
#pragma unroll
              for (int i = 0; i < 16; ++i) Ct[dkb][i] *= wc;
          if (VAR != 3)
#pragma unroll
          for (int k4 = 0; k4 < 4; ++k4) { const bf16x8 bv = vt[k4];
#pragma unroll
              for (int dkb = 0; dkb < 4; ++dkb) { const bf16x8 ak = *(const bf16x8*)(KwT + tswz(32 * dkb + r, 2 * k4 + h)); Ct[dkb] = MFMA32(ak, bv, Ct[dkb]); } }
          if (tid < 128) { float sn = 0.f;
#pragma unroll
              for (int j = 0; j < 8; ++j) { float k8[8]; unpack8(*(const u32x4*)(KwT + tid * 72 + 8 * j), k8); sn += ((k8[0] + k8[1]) + (k8[2] + k8[3])) + ((k8[4] + k8[5]) + (k8[6] + k8[7])); }
              nSn[tid] = wc * nS[tid] + sn; } }
        __syncthreads();
    }
#undef ML_ISSUE
    if (VAR == 0 && seq < 32 && a.ph_hi < 1000) {
        float* Co = a.out + OUT_C + sidx * 16384;
        if (tb == 0) {
#pragma unroll
            for (int dkb = 0; dkb < 4; ++dkb)
#pragma unroll
                for (int i = 0; i < 16; ++i) Co[(size_t)(32 * dkb + (i & 3) + 8 * (i >> 2) + 4 * h) * 128 + 32 * dvb + r] = Ct[dkb][i]; }
        if (tid < 128) a.out[OUT_N + sidx * 128 + tid] = nS0[128 * (nc & 1) + tid];
        if (tid == 0) a.out[OUT_M + sidx] = gWc[16]; }
}


__device__ __forceinline__ f32x4 conv4(const bf16* row, int t, int L, float w0, float w1, float w2) {
    const u32x2 m = *(const u32x2*)(row + t);
    const float x0 = bflo(m.x), x1 = bfhi(m.x), x2 = bflo(m.y), x3 = bfhi(m.y);
    const unsigned rm = row[t > 0 ? t - 1 : t], rp = row[(t + 4 < L) ? t + 4 : t];
    const float xm = t > 0 ? bflo(rm) : 0.f, xp = (t + 4 < L) ? bflo(rp) : 0.f;
    return (f32x4){w0 * xm + w1 * x0 + w2 * x1, w0 * x0 + w1 * x1 + w2 * x2, w0 * x1 + w1 * x2 + w2 * x3, w0 * x2 + w1 * x3 + w2 * xp};
}
struct Raw4 { u32x2 m; unsigned nb; };
__device__ __forceinline__ Raw4 conv4_load(const bf16* row, int t, int L) { Raw4 q; q.m = *(const u32x2*)(row + t); const unsigned rm = row[t > 0 ? t - 1 : t], rp = row[(t + 4 < L) ? t + 4 : t]; q.nb = rm | (rp << 16); return q; }
__device__ __forceinline__ f32x4 conv4_eval(const Raw4 q, int t, int L, float w0, float w1, float w2) {
    const float x0 = bflo(q.m.x), x1 = bfhi(q.m.x), x2 = bflo(q.m.y), x3 = bfhi(q.m.y);
    const float xm = t > 0 ? bflo(q.nb) : 0.f, xp = (t + 4 < L) ? bfhi(q.nb) : 0.f;
    return (f32x4){w0 * xm + w1 * x0 + w2 * x1, w0 * x0 + w1 * x1 + w2 * x2, w0 * x1 + w1 * x2 + w2 * x3, w0 * x2 + w1 * x3 + w2 * xp};
}
template <int L> __device__ __forceinline__ bf16x8 toep_frag(const bf16* Fw, int base) {
    const int kb = L - base;
    const unsigned* p = (const unsigned*)((kb & 1) ? Fw + 2 * L + (kb - 1) : Fw + kb);
    u32x4 f; f.x = p[0]; f.y = p[1]; f.z = p[4]; f.w = p[5];
    return __builtin_bit_cast(bf16x8, f);
}
__device__ __forceinline__ bf16x8 pack_f8(const f32x4 lo, const f32x4 hi) { u32x4 p; p.x = cvtpk(lo.x, lo.y); p.y = cvtpk(lo.z, lo.w); p.z = cvtpk(hi.x, hi.y); p.w = cvtpk(hi.z, hi.w); return __builtin_bit_cast(bf16x8, p); }
template <int L> __device__ __forceinline__ void hy_load_filter(const float* Gc, bf16* Fw, int lane) {
    constexpr int NIT = 2 * L / 128;
    float sa = 0.f;
#pragma unroll 8
    for (int e = 0; e < NIT; ++e) { const int j = e * 128 + 2 * lane; const f32x2_t x = *(const f32x2_t*)(Gc + j); sa += ((j == 0) ? 0.f : fabsf(x.x)) + fabsf(x.y); }
    sa = wave_sum(sa); const float inv = 1.0f / sa;
#pragma unroll 8
    for (int e = 0; e < NIT; ++e) { const int k = e * 128 + 2 * lane;
        const int j2 = 2 * L - k - 2; const f32x2_t x = *(const f32x2_t*)(Gc + (j2 >= 0 ? j2 : 0)); const float top = Gc[k > 0 ? 2 * L - k : 1];
        const float r0 = k > 0 ? top * inv : 0.f, r1 = x.y * inv, r2 = (j2 > 0) ? x.x * inv : 0.f;
        *(unsigned*)(Fw + k) = cvtpk(r0, r1); *(unsigned*)(Fw + 2 * L + k) = cvtpk(r1, r2); }
}
#define HY_WAVE_SYNC() do { asm volatile("s_waitcnt lgkmcnt(0)" ::: "memory"); __builtin_amdgcn_wave_barrier(); } while (0)

__device__ __forceinline__ void hyena_prompt_wave(CArgs& a, unsigned char* wlds, int l, int c) {
    const int lane = opaque_tid() & 63, r = lane & 31, h = lane >> 5;
    bf16* Fw = (bf16*)wlds;
    bf16x8* Zs = (bf16x8*)(wlds + 2048);
    const float* Gf = (const float*)(a.ws + WS_FILT) + (size_t)l * FILT_L;
    const bf16* HYT = (const bf16*)(a.ws + WS_HYT); bf16* YHT = (bf16*)(a.ws + WS_YHT);
    const float* cw = a.in[I_HYCW] + l * 3 * 768;
    const bf16* vrow = HYT + (size_t)c * NTOK + r * 256; const bf16* g1row = HYT + (size_t)(256 + c) * NTOK + r * 256; const bf16* g2row = HYT + (size_t)(512 + c) * NTOK + r * 256;
    const float vw0 = cw[c], vw1 = cw[768 + c], vw2 = cw[1536 + c];
    const float sk0 = a.in[I_HSKIP][l * 512 + c], sk1 = a.in[I_HSKIP][l * 512 + 256 + c];
    bf16x8 zf[16];
    { Raw4 zr[32];
#pragma unroll
      for (int ss = 0; ss < 16; ++ss) { zr[2 * ss] = conv4_load(vrow, 16 * ss + 4 * h, 256); zr[2 * ss + 1] = conv4_load(vrow, 16 * ss + 8 + 4 * h, 256); }
#pragma unroll
      for (int ss = 0; ss < 16; ++ss) zf[ss] = pack_f8(conv4_eval(zr[2 * ss], 16 * ss + 4 * h, 256, vw0, vw1, vw2), conv4_eval(zr[2 * ss + 1], 16 * ss + 8 + 4 * h, 256, vw0, vw1, vw2)); }
#pragma unroll 1
    for (int o = 0; o < 2; ++o) {
        HY_WAVE_SYNC();
        hy_load_filter<256>(Gf + (size_t)(o * 256 + c) * 512, Fw, lane);
        HY_WAVE_SYNC();
        const bf16* F = Fw;
        const bf16* grow = o ? g2row : g1row; const int gch = 256 * (o + 1) + c;
        const float gw0 = cw[gch], gw1 = cw[768 + gch], gw2 = cw[1536 + gch], sk = o ? sk1 : sk0;
#pragma unroll
        for (int half = 0; half < 2; ++half) {
            f32x16 acc[4];
#pragma unroll
            for (int q = 0; q < 4; ++q)
#pragma unroll
                for (int i = 0; i < 16; ++i) acc[q][i] = 0.f;
            Raw4 graw[4][4];
#pragma unroll
            for (int Tl = 0; Tl < 4; ++Tl)
#pragma unroll
                for (int g = 0; g < 4; ++g) graw[Tl][g] = conv4_load(grow, 32 * (4 * half + Tl) + 8 * g + 4 * h, 256);
            const int fb = 128 * half + r - 4 * h;
#pragma unroll
            for (int par = 0; par < 2; ++par) {
                bf16x8 A0 = toep_frag<256>(F, fb - 16 * par), A1 = toep_frag<256>(F, fb + 32 - 16 * par), A2 = toep_frag<256>(F, fb + 64 - 16 * par), A3 = toep_frag<256>(F, fb + 96 - 16 * par);
#pragma unroll
                for (int q = 0; q < 8; ++q) { const int ss = 2 * q + par;
                    acc[0] = MFMA32(A0, zf[ss], acc[0]); acc[1] = MFMA32(A1, zf[ss], acc[1]); acc[2] = MFMA32(A2, zf[ss], acc[2]); acc[3] = MFMA32(A3, zf[ss], acc[3]);
                    if (q < 7) { A3 = A2; A2 = A1; A1 = A0; A0 = toep_frag<256>(F, fb - 16 * (ss + 2)); } }
            }
#pragma unroll
            for (int Tl = 0; Tl < 4; ++Tl) { const int T = 4 * half + Tl;
                f32x16 zn;
#pragma unroll
                for (int g = 0; g < 4; ++g) { const f32x4 gt = conv4_eval(graw[Tl][g], 32 * T + 8 * g + 4 * h, 256, gw0, gw1, gw2);
                    const bf16x8 zz = zf[2 * T + (g >> 1)]; const u32x4 zu = __builtin_bit_cast(u32x4, zz);
                    const unsigned w0 = (g & 1) ? zu.z : zu.x, w1 = (g & 1) ? zu.w : zu.y;
                    zn[4 * g + 0] = gt.x * (acc[Tl][4 * g + 0] + sk * bflo(w0)); zn[4 * g + 1] = gt.y * (acc[Tl][4 * g + 1] + sk * bfhi(w0));
                    zn[4 * g + 2] = gt.z * (acc[Tl][4 * g + 2] + sk * bflo(w1)); zn[4 * g + 3] = gt.w * (acc[Tl][4 * g + 3] + sk * bfhi(w1)); }
                if (o == 0) { Zs[(2 * T) * 64 + lane] = pack8<0>(zn); Zs[(2 * T + 1) * 64 + lane] = pack8<1>(zn); }
                else { bf16* yp = YHT + (size_t)c * NTOK + r * 256 + 32 * T + 4 * h;
#pragma unroll
                    for (int g = 0; g < 4; ++g) { u32x2 ov; ov.x = cvtpk(zn[4 * g], zn[4 * g + 1]); ov.y = cvtpk(zn[4 * g + 2], zn[4 * g + 3]); *(u32x2*)(yp + 8 * g) = ov; } }
            }
        }
        if (o == 0) { HY_WAVE_SYNC();
#pragma unroll
            for (int ss = 0; ss < 16; ++ss) zf[ss] = Zs[ss * 64 + lane]; }
    }
}

__device__ __forceinline__ void hyena_sample_wave(CArgs& a, unsigned char* wlds, int l, int c) {
    const int lane = opaque_tid() & 63, r = lane & 31, h = lane >> 5;
    bf16* Fw = (bf16*)wlds;
    bf16* zb = (bf16*)(wlds + 8192);
    constexpr int ZSTR = 36, ZB1 = 32 * ZSTR, ZOFF = 2 * ZB1;
    const float* Gf = (const float*)(a.ws + WS_FILT) + (size_t)l * FILT_L + 262144;
    const bf16* HYT = (const bf16*)(a.ws + WS_HYT); bf16* YHT = (bf16*)(a.ws + WS_YHT);
    const float* cw = a.in[I_HYCW] + l * 3 * 768;
    HY_WAVE_SYNC();
    const bf16* vrow = HYT + (size_t)c * NTOK + NPT;
    { const float vw0 = cw[c], vw1 = cw[768 + c], vw2 = cw[1536 + c];
#pragma unroll
      for (int it = 0; it < 8; ++it) { const int idx = it * 64 + lane, nb = idx >> 8, t = (idx & 255) * 4;
          const f32x4 z = conv4(vrow + nb * 1024, t, 1024, vw0, vw1, vw2); u32x2 o; o.x = cvtpk(z.x, z.y); o.y = cvtpk(z.z, z.w); *(u32x2*)(zb + nb * ZB1 + (t >> 5) * ZSTR + (t & 31)) = o; } }
    if (lane < 24) *(unsigned*)(zb + ZOFF + 2 * lane) = 0u;
    HY_WAVE_SYNC();
#pragma unroll 1
    for (int o = 0; o < 2; ++o) {
        hy_load_filter<1024>(Gf + (size_t)(o * 256 + c) * 2048, Fw, lane);
        HY_WAVE_SYNC();
        const bf16* F = Fw;
        const int gch = 256 * (o + 1) + c; const bf16* grow = HYT + (size_t)gch * NTOK + NPT;
        const float gw0 = cw[gch], gw1 = cw[768 + gch], gw2 = cw[1536 + gch], sk = a.in[I_HSKIP][l * 512 + o * 256 + c];
        f32x16 acc0, acc1;
#pragma unroll
        for (int i = 0; i < 16; ++i) { acc0[i] = 0.f; acc1[i] = 0.f; }
#pragma unroll 1
        for (int dl = -31; dl <= 31; ++dl) { const int seg = r - dl; const bool valid = seg >= 0 && seg < 32; const int so = valid ? ZSTR * seg + 4 * h : ZOFF + 4 * h, so1 = valid ? ZB1 + ZSTR * seg + 4 * h : ZOFF + 4 * h;
#pragma unroll
            for (int kk = 0; kk < 2; ++kk) { const bf16x8 A = toep_frag<1024>(F, 32 * dl - 16 * kk + r - 4 * h);
                const s16x4 l0 = *(const s16x4*)(zb + so + 16 * kk), h0 = *(const s16x4*)(zb + so + 16 * kk + 8), l1 = *(const s16x4*)(zb + so1 + 16 * kk), h1 = *(const s16x4*)(zb + so1 + 16 * kk + 8);
                acc0 = MFMA32(A, join8(l0, h0), acc0); acc1 = MFMA32(A, join8(l1, h1), acc1); } }
#pragma unroll
        for (int nb = 0; nb < 2; ++nb)
#pragma unroll
            for (int g = 0; g < 4; ++g) { const int t = 32 * r + 8 * g + 4 * h;
                const f32x4 gt = conv4(grow + nb * 1024, t, 1024, gw0, gw1, gw2);
                const int zo = nb * ZB1 + r * ZSTR + 8 * g + 4 * h;
                const u32x2 zu = *(const u32x2*)(zb + zo);
                const f32x16& ac = nb ? acc1 : acc0;
                const float z0 = gt.x * (ac[4 * g + 0] + sk * bflo(zu.x)), z1 = gt.y * (ac[4 * g + 1] + sk * bfhi(zu.x)), z2 = gt.z * (ac[4 * g + 2] + sk * bflo(zu.y)), z3 = gt.w * (ac[4 * g + 3] + sk * bfhi(zu.y));
                u32x2 ov; ov.x = cvtpk(z0, z1); ov.y = cvtpk(z2, z3);
                if (o == 0) *(u32x2*)(zb + zo) = ov; else *(u32x2*)(YHT + (size_t)c * NTOK + NPT + nb * 1024 + t) = ov; }
        HY_WAVE_SYNC();
    }
}
__device__ __forceinline__ void hyena_item_mfma(CArgs& a, unsigned char* lds, int l, int item) {
    const int wave = __builtin_amdgcn_readfirstlane(opaque_tid() >> 6);
    unsigned char* wlds = lds + wave * 18432;
    __syncthreads();
    if (item < 32) hyena_sample_wave(a, wlds, l, item * 8 + wave);
    else hyena_prompt_wave(a, wlds, l, (item - 32) * 8 + wave);
}

__device__ __forceinline__ void mixer_phase(CArgs& a, unsigned char* lds, int l, int cidx) {
    unsigned* ctr = (unsigned*)(a.ws + WS_CTL) + 64 * cidx;
    volatile unsigned* slot = (volatile unsigned*)(lds + LDS_BYTES - 64);
    const int N_ITEMS = 16 + 32 + 256 + 32 + 80 + (l == 0 ? TR_DEFER_ITEMS : 0);
    for (;;) {
        __syncthreads();
        if (threadIdx.x == 0) *slot = atomicAdd(ctr, 1u);
        __syncthreads();
        const int it = __builtin_amdgcn_readfirstlane((int)*slot);
        if (it >= N_ITEMS) break;
        int kind, sub;
        if (it < 16) { kind = 0; sub = it; } else if (it < 48) { kind = 1; sub = it - 16 + 32; } else if (it < 304) { kind = 0; sub = it - 48 + 16; } else if (it < 336) { kind = 1; sub = it - 304; } else if (it < 416) { kind = 2; sub = it - 336; } else { kind = 3; sub = it - 416; }
#ifdef RK
        if (cidx >= 3) { const int cls = it < 16 ? 1 : it < 48 ? 8 : it < 304 ? 4 : it < 336 ? 2 : it < 416 ? 16 : 32; if (!((RK) & cls)) continue; }
#endif
        const __attribute__((address_space(4))) Args* ap2 = &a; asm volatile("" : "+s"(ap2)); CArgs& a2 = *ap2;
#ifdef DBGVAR
        if (kind == 0) { if (cidx >= 3) mlstm_item_mfma<DBGVAR>(a2, lds, l, sub); else mlstm_item_mfma<0>(a2, lds, l, sub); }
#else
        if (kind == 0) mlstm_item_mfma<0>(a2, lds, l, sub);
#endif
        else if (kind == 1) hyena_item_mfma(a2, lds, l, sub);
        else if (kind == 2) { for (int q = 0; q < 8; ++q) sc_item(a2, l, sub * 8 + q); }
        else if (l == 0) { const int q = trq_fetch(a2, lds); if (q < TR_DEFER_ITEMS) transpose_block_item(a2, lds, q); }
    }
}

__device__ __forceinline__ void combine_rows(CArgs& a, unsigned char* lds, int l, int tix0, int tixs, int tixe, int row0, int rows, int rowe) {
    const int tid = threadIdx.x, lane = tid & 63;
    {
        const bf16* YHT = (const bf16*)(a.ws + WS_YHT); bf16* Yo = (bf16*)(a.ws + WS_Y); bf16* tile = (bf16*)lds;
        for (int tix = tix0; tix < tixe; tix += tixs) { const int c0 = (tix & 3) * 64, t0 = (tix >> 2) * 64;
            __syncthreads();
            { const int ch = tid >> 3, pc = tid & 7; *(u32x4*)(tile + ch * 72 + 8 * pc) = *(const u32x4*)(YHT + (size_t)(c0 + ch) * NTOK + t0 + 8 * pc); }
            __syncthreads();
            { const int tk = tid >> 3, pc = tid & 7; unsigned short e[8];
#pragma unroll
              for (int q = 0; q < 8; ++q) e[q] = tile[(8 * pc + q) * 72 + tk];
              u32x4 o; o.x = e[0] | ((unsigned)e[1] << 16); o.y = e[2] | ((unsigned)e[3] << 16); o.z = e[4] | ((unsigned)e[5] << 16); o.w = e[6] | ((unsigned)e[7] << 16);
              *(u32x4*)(Yo + (size_t)(t0 + tk) * D + 256 + c0 + 8 * pc) = o; } }
    }
    const bf16* HF = (const bf16*)(a.ws + WS_HF); const bf16* HB = (const bf16*)(a.ws + WS_HB); const bf16* P = (const bf16*)(a.ws + WS_PROJ); bf16* Y = (bf16*)(a.ws + WS_Y);
    const float* ng = a.in[I_MLNG] + l * 512;
    constexpr int RB = 4; const int stride = rows;
    for (int r0 = row0; r0 < rowe; r0 += stride * RB) {
        u32x4 rf[RB], rb[RB], ro[RB];
#pragma unroll
        for (int k = 0; k < RB; ++k) { int r = r0 + k * stride; r = r < rowe ? r : rowe - 1;
            rf[k] = ld8(HF + (size_t)r * 512 + 8 * lane); rb[k] = ld8(HB + (size_t)r * 512 + 8 * lane); ro[k] = ld8(P + (size_t)r * PLD + ML_OFF + 1536 + 8 * lane); }
#pragma unroll
        for (int k = 0; k < RB; ++k) { const int r = r0 + k * stride; if (r < rowe) {
            float hf[8], hb[8], ov[8], h[8];
            unpack8(rf[k], hf); unpack8(rb[k], hb); unpack8(ro[k], ov);
            float ss = 0.f;
#pragma unroll
            for (int e = 0; e < 8; ++e) { h[e] = hf[e] + hb[e]; ss += h[e] * h[e]; }
            ss = DPP_ADD(ss, 0xB1); ss = DPP_ADD(ss, 0x4E); ss = DPP_ADD(ss, 0x141); ss = DPP_ADD(ss, 0x140);
            const float rstd = 1.0f / sqrtf(ss * (1.0f / 128.0f) + EPS);
#pragma unroll
            for (int e = 0; e < 8; ++e) h[e] = h[e] * rstd * ng[8 * lane + e] * sigmoid_f(ov[e]);
            u32x4 o; o.x = cvtpk(h[0], h[1]); o.y = cvtpk(h[2], h[3]); o.z = cvtpk(h[4], h[5]); o.w = cvtpk(h[6], h[7]);
            *(u32x4*)(Y + (size_t)r * D + 512 + 8 * lane) = o; } }
    }
}

#define XB_TMO      128
#define XB_XCNT(j)  (256  + 64 * (j))
#define XB_XSUB(j)  (1280 + 64 * (j))
#define XB_XGEN(j)  (2304 + 64 * (j))
#define XB_TOP      3328
#define XB_TOPGEN   3392
#define XCD_BAR_WORDS 3456
#define XB_SPIN_CAP (1u << 18)

__device__ __forceinline__ unsigned xb_ld(unsigned* p)              { return __hip_atomic_load(p, __ATOMIC_RELAXED, __HIP_MEMORY_SCOPE_AGENT); }
__device__ __forceinline__ unsigned xb_add(unsigned* p, unsigned v) { return __hip_atomic_fetch_add(p, v, __ATOMIC_RELAXED, __HIP_MEMORY_SCOPE_AGENT); }
__device__ __forceinline__ unsigned xb_xcc_id() { return (unsigned)__builtin_amdgcn_s_getreg((3 << 11) | 20) & 0xFu; }
#define XB_SPIN(cond, bar) do { unsigned _sp = 0; while (cond) { __builtin_amdgcn_s_sleep(1); \
    if ((++_sp & 255u) == 0u) { if (xb_ld(&(bar)[XB_TMO])) break; if (_sp > XB_SPIN_CAP) { atomicAdd(&(bar)[XB_TMO], 1u); break; } } } } while (0)

struct XcdBarrier {
    unsigned* bar; unsigned x;
    volatile LAS unsigned* st;
};

__device__ __forceinline__ XcdBarrier xcd_barrier_post(unsigned* bar, volatile LAS unsigned* st) {
    XcdBarrier b; b.bar = bar; b.x = xb_xcc_id(); b.st = st;
    if (threadIdx.x == 0) (void)xb_add(&bar[XB_XCNT(b.x)], 1u);
    return b;
}
__device__ __forceinline__ void xcd_barrier_complete(unsigned* bar, unsigned x, unsigned& nloc, unsigned& nx) {
    const unsigned G = gridDim.x * gridDim.y * gridDim.z;
    unsigned sum, cnt, mine, sp = 0u;
    for (;;) {
        sum = 0u; cnt = 0u; mine = 0u;
#pragma unroll
        for (unsigned j = 0; j < 16; ++j) { const unsigned c = xb_ld(&bar[XB_XCNT(j)]); sum += c; cnt += (c > 0u) ? 1u : 0u; mine = (j == x) ? c : mine; }
        if (sum == G) break;
        __builtin_amdgcn_s_sleep(1);
        if ((++sp & 255u) == 0u) { if (xb_ld(&bar[XB_TMO])) break; if (sp > XB_SPIN_CAP) { atomicAdd(&bar[XB_TMO], 1u); break; } }
    }
    nloc = mine > 0u ? mine : 1u; nx = cnt > 0u ? cnt : 1u;
}

__device__ __forceinline__ void xcd_barrier(const XcdBarrier& b) {
    asm volatile("s_waitcnt vmcnt(0)" ::: "memory");
    __syncthreads();
    if (threadIdx.x == 0) {
        unsigned* bar = b.bar;
        __builtin_amdgcn_s_waitcnt(0);
        unsigned nloc = b.st[0], nx = b.st[1];
        if (nloc == 0u) { xcd_barrier_complete(bar, b.x, nloc, nx); b.st[0] = nloc; b.st[1] = nx; }
        const unsigned old = xb_add(&bar[XB_XSUB(b.x)], 1u);
        const unsigned gen = old / nloc;
        if (old + 1u == (gen + 1u) * nloc) {
            __builtin_amdgcn_fence(__ATOMIC_RELEASE, "agent");
            asm volatile("s_waitcnt vmcnt(0)" ::: "memory");
            const unsigned og = xb_add(&bar[XB_TOP], 1u);
            const unsigned tg = og / nx;
            if (og + 1u == (tg + 1u) * nx) xb_add(&bar[XB_TOPGEN], 1u);
            else XB_SPIN(xb_ld(&bar[XB_TOPGEN]) == tg, bar);
            __builtin_amdgcn_fence(__ATOMIC_ACQUIRE, "agent");
            xb_add(&bar[XB_XGEN(b.x)], 1u);
            asm volatile("s_waitcnt vmcnt(0)" ::: "memory");
        } else {
            XB_SPIN(xb_ld(&bar[XB_XGEN(b.x)]) == gen, bar);
            __builtin_amdgcn_fence(__ATOMIC_ACQUIRE, "agent");
            asm volatile("s_waitcnt vmcnt(0)" ::: "memory");
        }
    }
    __syncthreads();
}

__device__ __forceinline__ XcdBarrier xcd_barrier_make() {
    const __attribute__((address_space(4))) Args* ap_ = (const __attribute__((address_space(4))) Args*)__builtin_amdgcn_kernarg_segment_ptr(); asm volatile("" : "+s"(ap_));
    extern __shared__ __attribute__((aligned(16))) unsigned char lds_[];
    XcdBarrier b; b.bar = (unsigned*)(ap_->ws + WS_CTL) + 4096; b.x = xb_xcc_id(); b.st = (volatile LAS unsigned*)((LAS unsigned char*)lds_ + LDS_BYTES - 32); return b;
}
constexpr int N_PHASES = 11;
#ifndef REPEAT_PH
#define REPEAT_PH (-1)
#endif
constexpr size_t CTL_PANEL = 32768;
#define LAYER_PHASES(l, pb) do { \
        if (IN(pb)) { \
            PHASE_ARGS(); unsigned char* ws = a.ws; \
            const bf16* wt = (const bf16*)(ws + WS_WIN) + (size_t)l * NPROJ * 1024; \
            { pg8::Gemm g{(const bf16*)(ws + WS_U), wt, NTOK, PLD, 1024}; pg8::StaticOrder S; S.init(NTOK, PLD, G, (int)blockIdx.x); \
              EpiBf16<0> E{(bf16*)(ws + WS_PROJ), PLD}; \
              pg8::gemm_phase<EpiBf16<0>, pg8::StaticOrder, true, true>((PG8_LAS unsigned char*)lds, g, S, E); } \
            { pg8::Gemm g{wt + (size_t)PLD * 1024, (const bf16*)(ws + WS_U), 768, NTOK, 1024}; pg8::StaticOrder S; S.init(768, NTOK, G, (int)blockIdx.x); \
              EpiBf16<0> E{(bf16*)(ws + WS_HYT), NTOK}; \
              pg8::gemm_phase<EpiBf16<0>, pg8::StaticOrder, true, true>((PG8_LAS unsigned char*)lds, g, S, E); } \
            if (l == 1) { norm_wg_load(a, lds, 1); for (;;) { volatile unsigned* sl_ = (volatile unsigned*)(lds + LDS_BYTES - 320); __syncthreads(); if (threadIdx.x == 0) *sl_ = atomicAdd((unsigned*)(ws + WS_CTL) + 64 * 15, 1u); __syncthreads(); \
                    const int q_ = __builtin_amdgcn_readfirstlane((int)*sl_); if (q_ >= 256) break; gates_block_item(a, lds, 1, q_); } }     \
            if (l == 0) { const int b_ = (int)blockIdx.x; const int nu = (b_ < 440 - 256 ? 2 : 1) + (b_ < 120 ? 1 : 0); \
                for (int q_ = 0; q_ < (3 - nu) * TR_QUOTA; ++q_) { const int it_ = trq_fetch(a, lds); if (it_ >= TR_DEFER_ITEMS) break; transpose_block_item(a, lds, it_); } } \
        } SEAM(pb); \
        if (IN(pb + 1)) { PHASE_ARGS(); mixer_phase(a, lds, l, 1 + l); if (REPEAT_PH == pb + 1) { xcd_barrier(XBAR_NOW()); mixer_phase(a, lds, l, 3 + l); } } SEAM(pb + 1); \
        if (IN(pb + 2)) { \
            PHASE_ARGS(); unsigned char* ws = a.ws; const float* mod = (const float*)(ws + WS_MOD) + (size_t)l * 3 * 6144; \
            pg8::Gemm g{(const bf16*)(ws + WS_Y), (const bf16*)(ws + WS_WOUT) + (size_t)l * 1024 * 1024, NTOK, 1024, 1024}; pg8::StaticOrder S; S.init(NTOK, 1024, G, (int)blockIdx.x); \
            {     \
                unsigned* cb_ = (unsigned*)(ws + WS_CTL) + CTL_PANEL + (4 + l) * 4096; const int b_ = (int)blockIdx.x; \
                combine_rows(a, lds, l, b_, 256, 640, 40 * b_ + (int)(threadIdx.x >> 6), 8, 40 * b_ + 40); \
                asm volatile("s_waitcnt vmcnt(0)" ::: "memory"); __syncthreads(); \
                if (threadIdx.x == 0) { __builtin_amdgcn_fence(__ATOMIC_RELEASE, "agent"); asm volatile("s_waitcnt vmcnt(0)" ::: "memory"); \
                    const int r0_ = 40 * b_, p0_ = r0_ >> 8, p1_ = (r0_ + 39) >> 8; \
                    if (p0_ == p1_) (void)__hip_atomic_fetch_add(cb_ + 64 * p0_, 40u, __ATOMIC_RELAXED, __HIP_MEMORY_SCOPE_AGENT); \
                    else { const unsigned n0_ = (unsigned)(256 * p1_ - r0_); (void)__hip_atomic_fetch_add(cb_ + 64 * p0_, n0_, __ATOMIC_RELAXED, __HIP_MEMORY_SCOPE_AGENT); (void)__hip_atomic_fetch_add(cb_ + 64 * p1_, 40u - n0_, __ATOMIC_RELAXED, __HIP_MEMORY_SCOPE_AGENT); } \
                    for (int tx_ = b_; tx_ < 640; tx_ += 256) (void)__hip_atomic_fetch_add(cb_ + 64 * (tx_ >> 4), 16u, __ATOMIC_RELAXED, __HIP_MEMORY_SCOPE_AGENT); } \
                pg8::Unit u0; if (first_unit(NTOK / 256, 4, b_, u0)) { \
                    if (threadIdx.x == 0) { unsigned* c_ = cb_ + 64 * u0.pm; unsigned sp_ = 0; \
                        while (__hip_atomic_load(c_, __ATOMIC_RELAXED, __HIP_MEMORY_SCOPE_AGENT) < 512u && ++sp_ < (1u << 22)) __builtin_amdgcn_s_sleep(1); \
                        __builtin_amdgcn_fence(__ATOMIC_ACQUIRE, "agent"); asm volatile("s_waitcnt vmcnt(0)" ::: "memory"); } \
                    __syncthreads(); } } \
            EpiResid E{a.ph_hi >= 1000 ? (float*)(ws + WS_PROJ) : a.out, mod + 2048}; \
            pg8::gemm_phase<EpiResid, pg8::StaticOrder, true, true>((PG8_LAS unsigned char*)lds, g, S, E); \
            panel_tail<false, false>(a, lds, l, 2, (unsigned*)(ws + WS_CTL) + CTL_PANEL + (2 * l) * 4096, S); \
        } SEAM(pb + 2); \
        if (IN(pb + 3)) { \
            PHASE_ARGS(); unsigned char* ws = a.ws; \
            pg8::Gemm g{(const bf16*)(ws + WS_U), (const bf16*)(ws + WS_W1) + (size_t)l * DFF * 1024, NTOK, DFF, 1024}; pg8::StaticOrder S; S.init(NTOK, DFF, G, (int)blockIdx.x); \
            EpiBf16<1> E{(bf16*)(ws + WS_PROJ), DFF}; \
            pg8::gemm_phase<EpiBf16<1>, pg8::StaticOrder, true, true>((PG8_LAS unsigned char*)lds, g, S, E); \
            if (REPEAT_PH == 100 + pb + 3) { xcd_barrier(XBAR_NOW()); pg8::gemm_phase<EpiBf16<1>, pg8::StaticOrder, true, true>((PG8_LAS unsigned char*)lds, g, S, E); } \
            if (REPEAT_PH == 200 + pb + 3) { for (int q_ = 0; q_ < 10; ++q_) xcd_barrier(XBAR_NOW()); } \
        } SEAM(pb + 3); \
        if (IN(pb + 4)) { \
            PHASE_ARGS(); unsigned char* ws = a.ws; const float* mod = (const float*)(ws + WS_MOD) + (size_t)l * 3 * 6144; \
            pg8::Gemm g{(const bf16*)(ws + WS_PROJ), (const bf16*)(ws + WS_W2) + (size_t)l * 1024 * DFF, NTOK, 1024, DFF}; pg8::StaticOrder S; S.init(NTOK, 1024, G, (int)blockIdx.x); \
            if (l == 0 && (int)blockIdx.x >= 160) {     \
                for (;;) { volatile unsigned* sl_ = (volatile unsigned*)(lds + LDS_BYTES - 320); __syncthreads(); if (threadIdx.x == 0) *sl_ = atomicAdd((unsigned*)(ws + WS_CTL) + 64 * 13, 1u); __syncthreads(); \
                    const int q_ = __builtin_amdgcn_readfirstlane((int)*sl_); if (q_ >= TR_L1_ITEMS + 80) break; \
                    if (q_ < TR_L1_ITEMS) transpose_block_item(a, lds, q_, TR_PER, 2 * TR_PER); else filter_block_item(a, lds, 80 + q_ - TR_L1_ITEMS); } } \
            EpiResid E{a.ph_hi >= 1000 ? (float*)(ws + WS_U) : a.out, mod + 5120}; \
            pg8::gemm_phase<EpiResid, pg8::StaticOrder, true, true>((PG8_LAS unsigned char*)lds, g, S, E); \
            if (REPEAT_PH == 300 + pb + 4) { xcd_barrier(XBAR_NOW()); EpiBf16<0> E2{(bf16*)(ws + WS_Y), 1024}; pg8::gemm_phase<EpiBf16<0>, pg8::StaticOrder, true, true>((PG8_LAS unsigned char*)lds, g, S, E2); } \
            if (l == 0) panel_tail<false, false>(a, lds, 1, 1, (unsigned*)(ws + WS_CTL) + CTL_PANEL + 1 * 4096, S);     \
            else panel_tail<false, true>(a, lds, 0, 0, (unsigned*)(ws + WS_CTL) + CTL_PANEL + 3 * 4096, S); \
        } if ((pb) + 4 < N_PHASES - 1) SEAM(pb + 4); \
    } while (0)

__global__ void __launch_bounds__(512, 2) mk_fwd(Args a_) {
    extern __shared__ __attribute__((aligned(16))) unsigned char lds[];
    cg::grid_group grid = cg::this_grid();
    volatile LAS unsigned* bst = (volatile LAS unsigned*)((LAS unsigned char*)lds + LDS_BYTES - 32);
    if (threadIdx.x < 2) bst[threadIdx.x] = 0u;
    __syncthreads();
    (void)xcd_barrier_post((unsigned*)(a_.ws + WS_CTL) + 4096, bst);
#define XBAR_NOW() xcd_barrier_make()
    const int lo = a_.ph_lo, hi = a_.ph_hi >= 1000 ? a_.ph_hi - 1000 : a_.ph_hi;
    const int G = gridDim.x;
#define IN(k) (lo <= (k) && (k) < hi)
#define SEAM(k) do { if (IN(k) && IN((k) + 1)) { if ((k) == 0) grid.sync(); else xcd_barrier(XBAR_NOW()); } } while (0)
    if (IN(0)) { PHASE_ARGS(); p0_prologue(a, lds);
        unsigned* ctl = (unsigned*)(a.ws + WS_CTL);
        __syncthreads();
        if (threadIdx.x == 0) { unsigned sp_ = 0; while (__hip_atomic_load(ctl + 64 * 11, __ATOMIC_RELAXED, __HIP_MEMORY_SCOPE_AGENT) < 192u && ++sp_ < (1u << 22)) __builtin_amdgcn_s_sleep(1);
            __builtin_amdgcn_fence(__ATOMIC_ACQUIRE, "agent"); asm volatile("s_waitcnt vmcnt(0)" ::: "memory"); }
        __syncthreads();
        volatile unsigned* nslot = (volatile unsigned*)(lds + LDS_BYTES - 256);
        norm_wg_load(a, lds, 0);
        for (;;) {
            __syncthreads();
            if (threadIdx.x == 0) *nslot = atomicAdd(ctl + 64 * 12, 1u);
            __syncthreads();
            const int it = __builtin_amdgcn_readfirstlane((int)*nslot);
            if (it >= 256 || (PV == 2 && a.ph_hi >= 1000)) break;
            const __attribute__((address_space(4))) Args* ap2 = &a; asm volatile("" : "+s"(ap2)); CArgs& a2 = *ap2;
            norm_rows<0, true, false>(a2, lds, 0, 1, 40 * it + (opaque_tid() >> 6), 8, 40 * it + 40, false);
        }
    } SEAM(0);
    LAYER_PHASES(0, 1);
    LAYER_PHASES(1, 6);
#undef IN
#undef SEAM
}

#ifdef DBG_STOP
__global__ void dbg_dump(const unsigned short* buf, size_t n16, float* out, int mode) {
    const size_t cap = mode == 2 ? 8388608 : 10485760, base = mode == 2 ? OUT_C : 0;
    const size_t n = n16 / DBG_E < cap ? n16 / DBG_E : cap;
    for (size_t i = (size_t)blockIdx.x * blockDim.x + threadIdx.x; i < cap; i += (size_t)gridDim.x * blockDim.x) {
        float v = 1.f;
        if (i < n) { v = 0.f; for (int e = 0; e < DBG_E; ++e) v += bflo(buf[DBG_E * i + e]); }
        out[base + i] = v;
    }
}
#endif

#ifdef DBG2_K
__global__ void dbg2_cmp(const unsigned* a, const unsigned* b, size_t nwords, int isf32, unsigned* res) {
    unsigned cnt = 0; float mx = 0.f;
    for (size_t i = (size_t)blockIdx.x * blockDim.x + threadIdx.x; i < nwords; i += (size_t)gridDim.x * blockDim.x) {
        const unsigned x = a[i], y = b[i];
        if (x != y) { ++cnt; float d;
            if (isf32) d = fabsf(__builtin_bit_cast(float, x) - __builtin_bit_cast(float, y));
            else d = fmaxf(fabsf(bflo(x & 0xffffu) - bflo(y & 0xffffu)), fabsf(bfhi(x) - bfhi(y)));
            if (!(d == d)) d = 1e30f; mx = fmaxf(mx, d); } }
    if (cnt) { atomicAdd(res, cnt); atomicMax(res + 1, __builtin_bit_cast(unsigned, mx)); }
}
__global__ void dbg2_fill(const unsigned* res, float* out, size_t n) {
    const unsigned cnt = res[0]; const float mx = __builtin_bit_cast(float, res[1]);
    float V;
    if (cnt == 0) V = 5e35f;
    else { const float mant = 1.0f + log10f((float)cnt); int e = (int)floorf(log10f(fmaxf(mx, 1e-12f))); if (e < -12) e = -12; if (e > 12) e = 12; V = mant * powf(10.f, (float)(20 + e)); }
    for (size_t i = (size_t)blockIdx.x * blockDim.x + threadIdx.x; i < n; i += (size_t)gridDim.x * blockDim.x) out[i] = V;
}
#endif
extern "C" void kernel_launch(void* const* d_in, const int* in_sizes, int n_in, void* d_out, int out_size, void* d_ws, size_t ws_size, hipStream_t stream) {
    static int grid = 0;
    if (grid == 0) {
        if (n_in != 28 || ws_size < WS_END) { fprintf(stderr, "kernel_launch: unexpected n_in %d / ws_size %zu\n", n_in, ws_size); grid = -1; return; }
        int dev = 0, cus = 0, per_cu = 0;
        (void)hipGetDevice(&dev); (void)hipDeviceGetAttribute(&cus, hipDeviceAttributeMultiprocessorCount, dev);
        if (hipFuncSetAttribute((const void*)mk_fwd, hipFuncAttributeMaxDynamicSharedMemorySize, LDS_BYTES) != hipSuccess) { fprintf(stderr, "kernel_launch: hipFuncSetAttribute failed\n"); grid = -1; return; }
        if (hipOccupancyMaxActiveBlocksPerMultiprocessor(&per_cu, (const void*)mk_fwd, 512, LDS_BYTES) != hipSuccess || per_cu < 1) { fprintf(stderr, "kernel_launch: occupancy query says %d\n", per_cu); per_cu = 1; }
        (void)hipGetLastError();
        grid = cus * 1;
        fprintf(stderr, "kernel_launch: cus %d per_cu %d grid %d ws %zu\n", cus, per_cu, grid, ws_size);
    }
    if (grid < 0) return;
    (void)hipMemsetAsync((char*)d_ws + WS_CTL, 0, CTL_BYTES, stream);
    Args a{};
    for (int i = 0; i < 28; ++i) a.in[i] = (const float*)d_in[i];
    a.out = (float*)d_out; a.ws = (unsigned char*)d_ws;
#if MK_ONE_LAUNCH
    a.ph_lo = 0; a.ph_hi = N_PHASES;
    void* args[] = {&a};
    hipError_t e = hipLaunchCooperativeKernel((const void*)mk_fwd, dim3(grid), dim3(512), args, LDS_BYTES, stream);
    if (e != hipSuccess) fprintf(stderr, "kernel_launch: cooperative launch failed: %s\n", hipGetErrorString(e));
#ifdef PROBE_PHASE
    { Args b = a; b.ph_lo = PROBE_PHASE; b.ph_hi = 1000 + PROBE_PHASE + 1; void* args2[] = {&b};
      (void)hipMemsetAsync((char*)d_ws + WS_CTL, 0, CTL_BYTES, stream);
      (void)hipLaunchCooperativeKernel((const void*)mk_fwd, dim3(grid), dim3(512), args2, LDS_BYTES, stream); }
#endif
#else
#ifdef DBG2_K
    (void)hipMemsetAsync((char*)d_ws + (250u << 20), 0, 256, stream);
    for (int rep = 0; rep < 2; ++rep) {
        for (int p = 0; p < DBG2_K; ++p) { a.ph_lo = p; a.ph_hi = p + 1; hipLaunchKernelGGL(mk_fwd, dim3(grid), dim3(512), LDS_BYTES, stream, a); }
        if (rep == 0) (void)hipMemcpyAsync((char*)d_ws + (208u << 20), DBG2_SRC, (size_t)(DBG2_BYTES), hipMemcpyDeviceToDevice, stream);
    }
    hipLaunchKernelGGL(dbg2_cmp, dim3(1024), dim3(256), 0, stream, (const unsigned*)((const char*)d_ws + (208u << 20)), (const unsigned*)(DBG2_SRC), (size_t)(DBG2_BYTES) / 4, (int)(DBG2_F32), (unsigned*)((char*)d_ws + (250u << 20)));
    hipLaunchKernelGGL(dbg2_fill, dim3(1024), dim3(256), 0, stream, (const unsigned*)((const char*)d_ws + (250u << 20)), (float*)d_out, (size_t)out_size);
#elif defined(DBG_STOP)
    for (int p = 0; p < DBG_STOP; ++p) { a.ph_lo = p; a.ph_hi = p + 1; hipLaunchKernelGGL(mk_fwd, dim3(grid), dim3(512), LDS_BYTES, stream, a); }
    hipLaunchKernelGGL(dbg_dump, dim3(1024), dim3(256), 0, stream, (const unsigned short*)((const char*)d_ws + (size_t)(DBG_OFF)), (size_t)(DBG_BYTES) / 2, (float*)d_out, (int)(DBG_KEEP));
#else
    for (int p = 0; p < N_PHASES; ++p) { a.ph_lo = p; a.ph_hi = p + 1; hipLaunchKernelGGL(mk_fwd, dim3(grid), dim3(512), LDS_BYTES, stream, a); }
#endif
#endif
}
```
